# Optimizing an MI355X kernel written in HIP

```python
import jax, jax.numpy as jnp
from jax import lax
import numpy as np

D_MODEL = 1024
BATCH = 8
SEQ = 2048
DEPTH = 4
DEC_BATCH = 32
DEC_SEQ = 8
PAST_LEN = 16384
PAGE_SIZE = 128

N_A_LAYERS = DEPTH // 2
N_B_LAYERS = DEPTH - N_A_LAYERS
MIX_W = D_MODEL
MEM_HEADS = 4
MEM_HEAD_DIM = 64
MEM_W = MEM_HEADS * MEM_HEAD_DIM
N_MEM = 256
POOL_W = MIX_W - MEM_W
POOL_WINDOWS = (2, 4, 8, 16)
POOL_GROUPS = len(POOL_WINDOWS)
POOL_GROUP_W = POOL_W // POOL_GROUPS
POOL_STATE = max(POOL_WINDOWS) - 1
MLA_HEADS = 12
QK_NOPE = 64
QK_ROPE = 32
QK_DIM = QK_NOPE + QK_ROPE
V_HEAD = 64
KV_LORA = 256
Q_LORA = 384
KV_ROW = KV_LORA + QK_ROPE
ROPE_BASE = 10000.0
D_FF = -(-(8 * D_MODEL) // (3 * 256)) * 256
Q_BLOCK = 128
EPS = 1e-6
NEG = -1e30

kernel_name = 'yoco_pool_mla_memory_decoder_step'


def rmsnorm(x, g):
    xf = x.astype(jnp.float32)
    y = xf * lax.rsqrt(jnp.mean(xf * xf, axis=-1, keepdims=True) + EPS)
    return (y * g.astype(jnp.float32)).astype(x.dtype)


def rope(x, pos):
    half = x.shape[-1] // 2
    inv_freq = ROPE_BASE ** (-jnp.arange(half, dtype=jnp.float32) / half)
    ang = pos.astype(jnp.float32)[:, None] * inv_freq[None, :]
    shape = (1, pos.shape[0]) + (1,) * (x.ndim - 3) + (half,)
    cos = jnp.cos(ang).reshape(shape)
    sin = jnp.sin(ang).reshape(shape)
    xf = x.astype(jnp.float32)
    x1, x2 = xf[..., :half], xf[..., half:]
    return jnp.concatenate([x1 * cos - x2 * sin, x1 * sin + x2 * cos], axis=-1).astype(x.dtype)


def pool_mixer(u, prev, pos, w_grp, scale):
    b, s, _ = u.shape
    p_len = prev.shape[1]
    ext = jnp.concatenate([prev.astype(u.dtype), u], axis=1)
    csum = jnp.pad(jnp.cumsum(ext.astype(jnp.float32), axis=1), ((0, 0), (1, 0), (0, 0)))
    outs = []
    for g, w in enumerate(POOL_WINDOWS):
        sl = slice(g * POOL_GROUP_W, (g + 1) * POOL_GROUP_W)
        win_sum = csum[:, p_len + 1:p_len + s + 1, sl] - csum[:, p_len + 1 - w:p_len + s + 1 - w, sl]
        cnt = jnp.minimum(w, pos + 1).astype(jnp.float32)
        outs.append(win_sum / cnt[None, :, None])
    pooled = jnp.stack(outs, axis=2)
    diff = (pooled - u.astype(jnp.float32).reshape(b, s, POOL_GROUPS, POOL_GROUP_W)).astype(u.dtype)
    mixed = jnp.einsum('bsgc,gce->bsge', diff, w_grp).reshape(b, s, POOL_W)
    return mixed * scale, ext[:, -p_len:]


def memory_kv(mem, norm_mem, w_mem_kv, g_mem_k):
    b, m, _ = mem.shape
    mf = mem.astype(jnp.float32)
    hm = mf * lax.rsqrt(jnp.mean(mf * mf, axis=-1, keepdims=True) + EPS)
    hm = (hm[None] * norm_mem.astype(jnp.float32)[:, None, None, :]).astype(mem.dtype)
    kv = jnp.einsum('lbmd,lde->lbme', hm, w_mem_kv)
    k = kv[..., :MEM_W].reshape(DEPTH, b, m, MEM_HEADS, MEM_HEAD_DIM)
    k = rmsnorm(k, g_mem_k[:, None, None, None, :])
    v = kv[..., MEM_W:].reshape(DEPTH, b, m, MEM_HEADS, MEM_HEAD_DIM)
    return k, v


def mem_attend(qm, mk, mv, g_q):
    b, s, _ = qm.shape
    q = rmsnorm(qm.reshape(b, s, MEM_HEADS, MEM_HEAD_DIM), g_q)
    sc = jnp.einsum('bshd,bmhd->bhsm', q, mk).astype(jnp.float32) * MEM_HEAD_DIM ** -0.5
    p = jax.nn.softmax(sc, axis=-1).astype(mv.dtype)
    return jnp.einsum('bhsm,bmhd->bshd', p, mv).reshape(b, s, MEM_W)


def shared_kv_rows(x, pos, norm_kv, w_dkv, g_kv_lora):
    h = rmsnorm(x, norm_kv)
    ck = h @ w_dkv
    c = rmsnorm(ck[..., :KV_LORA], g_kv_lora)
    kr = rope(ck[..., KV_LORA:], pos)
    return jnp.concatenate([c, kr], axis=-1)


def key_inv_rms(kv, w_uk):
    def one(rows):
        kn = (rows[:, :KV_LORA] @ w_uk).astype(jnp.float32).reshape(rows.shape[0], MLA_HEADS, QK_NOPE)
        kr = rows[:, KV_LORA:].astype(jnp.float32)
        ss = jnp.sum(kn * kn, axis=-1) + jnp.sum(kr * kr, axis=-1, keepdims=True)
        return lax.rsqrt(ss / QK_DIM + EPS)
    return lax.map(one, kv)


def mla_queries(cq_raw, pos, g_q_lora, w_uq, g_q, g_k_nope, g_k_rope, w_uk):
    b, s, _ = cq_raw.shape
    cq = rmsnorm(cq_raw, g_q_lora)
    q = rmsnorm((cq @ w_uq).reshape(b, s, MLA_HEADS, QK_DIM), g_q)
    q_nope = q[..., :QK_NOPE] * g_k_nope
    q_rope = rope(q[..., QK_NOPE:], pos) * jnp.concatenate([g_k_rope, g_k_rope])
    q_lat = jnp.einsum('bshd,chd->bshc', q_nope, w_uk.reshape(KV_LORA, MLA_HEADS, QK_NOPE))
    return q_lat, q_rope


def mla_attend(q_lat, q_rope, q_pos, kv, k_inv, k_pos):
    c = kv[..., :KV_LORA]
    kr = kv[..., KV_LORA:]
    sc = jnp.einsum('bshc,bkc->bhsk', q_lat, c) + jnp.einsum('bshr,bkr->bhsk', q_rope, kr)
    sc = sc.astype(jnp.float32) * jnp.swapaxes(k_inv, 1, 2)[:, :, None, :] * QK_DIM ** -0.5
    sc = jnp.where((k_pos[None, :] <= q_pos[:, None])[None, None], sc, NEG)
    p = jax.nn.softmax(sc, axis=-1).astype(c.dtype)
    return jnp.einsum('bhsk,bkc->bshc', p, c)


def mla_blocked(q_lat, q_rope, q_pos, kv, k_inv, k_pos):
    b, s = q_lat.shape[0], q_lat.shape[1]
    if s > Q_BLOCK and s % Q_BLOCK == 0:
        nb = s // Q_BLOCK
        def split(a):
            return jnp.moveaxis(a.reshape((b, nb, Q_BLOCK) + a.shape[2:]), 1, 0)
        out = lax.map(lambda blk: mla_attend(blk[0], blk[1], blk[2], kv, k_inv, k_pos),
                      (split(q_lat), split(q_rope), q_pos.reshape(nb, Q_BLOCK)))
        return jnp.moveaxis(out, 0, 1).reshape((b, s) + out.shape[3:])
    return mla_attend(q_lat, q_rope, q_pos, kv, k_inv, k_pos)


def trunk(x, pos, pool_prev, mem_k, mem_v, kv_past, p):
    b, s, _ = x.shape
    pool_new = []
    kv_new = None
    for l in range(DEPTH):
        h = rmsnorm(x, p['norm_mix'][l])
        if l < N_A_LAYERS:
            proj = h @ p['w_in_a'][l]
            tok, st = pool_mixer(proj[..., :POOL_W], pool_prev[l], pos, p['w_pool_grp'][l], p['pool_scale'][l])
            pool_new.append(st)
            qm = proj[..., POOL_W:]
        else:
            j = l - N_A_LAYERS
            if j == 0:
                kv_new = shared_kv_rows(x, pos, p['norm_kv'], p['w_dkv'], p['g_kv_lora'])
                kv_all = kv_new if kv_past is None else jnp.concatenate([kv_past, kv_new.astype(kv_past.dtype)], axis=1)
                k_inv = key_inv_rms(kv_all, p['w_uk'])
                k_pos = jnp.arange(kv_all.shape[1])
            proj = h @ p['w_in_b'][j]
            q_lat, q_rope = mla_queries(proj[..., :Q_LORA], pos, p['g_q_lora'][j], p['w_uq'][j], p['g_q'][j],
                                        p['g_k_nope'], p['g_k_rope'], p['w_uk'])
            o_lat = mla_blocked(q_lat, q_rope, pos, kv_all, k_inv, k_pos)
            tok = jnp.einsum('bshc,chd->bshd', o_lat,
                             p['w_uv'].reshape(KV_LORA, MLA_HEADS, V_HEAD)).reshape(b, s, MLA_HEADS * V_HEAD)
            qm = proj[..., Q_LORA:]
        mo = mem_attend(qm, mem_k[l], mem_v[l], p['g_mem_q'][l])
        x = x + jnp.concatenate([tok, mo], axis=-1) @ p['w_out'][l]
        gu = rmsnorm(x, p['norm_ffn'][l]) @ p['w_ffn_in'][l]
        x = x + (jax.nn.silu(gu[..., :D_FF]) * gu[..., D_FF:]) @ p['w_ffn_out'][l]
    return x, kv_new, jnp.stack(pool_new)


def setup_inputs(seed: int = 0) -> dict:
    key = jax.random.key(seed)
    keys = jax.random.split(key, 40)
    ctr = [0]
    def nk():
        ctr[0] += 1
        return keys[ctr[0] - 1]
    def nrm(shape, scale=1.0):
        return jax.random.normal(nk(), shape, jnp.float32) * scale
    def gain(shape):
        return 1.0 + 0.1 * jax.random.normal(nk(), shape, jnp.float32)
    n_pages = PAST_LEN // PAGE_SIZE
    n_used = DEC_BATCH * n_pages
    n_pool = n_used + (n_used + 3) // 4
    d = {}
    d['x_prompt'] = nrm((BATCH, SEQ, D_MODEL))
    d['x_sample'] = nrm((DEC_BATCH, DEC_SEQ, D_MODEL))
    d['cache_kv'] = nrm((n_pool, PAGE_SIZE, KV_ROW))
    d['state_pool'] = nrm((N_A_LAYERS, DEC_BATCH, POOL_STATE, POOL_W))
    d['cache_mem_k'] = nrm((DEPTH, DEC_BATCH, N_MEM, MEM_HEADS, MEM_HEAD_DIM))
    d['cache_mem_v'] = nrm((DEPTH, DEC_BATCH, N_MEM, MEM_HEADS, MEM_HEAD_DIM))
    perm = jax.random.permutation(nk(), n_pool).astype(jnp.int32)
    d['page_table'] = perm[:n_used].reshape(DEC_BATCH, n_pages)
    d['mem_prompt'] = nrm((BATCH, N_MEM, D_MODEL))
    d['norm_mix'] = gain((DEPTH, D_MODEL))
    d['norm_ffn'] = gain((DEPTH, D_MODEL))
    d['w_out'] = nrm((DEPTH, MIX_W, D_MODEL), MIX_W ** -0.5)
    d['w_ffn_in'] = nrm((DEPTH, D_MODEL, 2 * D_FF), D_MODEL ** -0.5)
    d['w_ffn_out'] = nrm((DEPTH, D_FF, D_MODEL), D_FF ** -0.5)
    d['norm_mem'] = gain((DEPTH, D_MODEL))
    d['w_mem_kv'] = nrm((DEPTH, D_MODEL, 2 * MEM_W), D_MODEL ** -0.5)
    d['g_mem_q'] = gain((DEPTH, MEM_HEAD_DIM))
    d['g_mem_k'] = gain((DEPTH, MEM_HEAD_DIM))
    d['w_in_a'] = nrm((N_A_LAYERS, D_MODEL, POOL_W + MEM_W), D_MODEL ** -0.5)
    d['w_pool_grp'] = nrm((N_A_LAYERS, POOL_GROUPS, POOL_GROUP_W, POOL_GROUP_W), POOL_GROUP_W ** -0.5)
    d['pool_scale'] = gain((N_A_LAYERS, POOL_W))
    d['w_in_b'] = nrm((N_B_LAYERS, D_MODEL, Q_LORA + MEM_W), D_MODEL ** -0.5)
    d['g_q_lora'] = gain((N_B_LAYERS, Q_LORA))
    d['w_uq'] = nrm((N_B_LAYERS, Q_LORA, MLA_HEADS * QK_DIM), Q_LORA ** -0.5)
    d['g_q'] = gain((N_B_LAYERS, QK_DIM))
    d['norm_kv'] = gain((D_MODEL,))
    d['w_dkv'] = nrm((D_MODEL, KV_ROW), D_MODEL ** -0.5)
    d['g_kv_lora'] = gain((KV_LORA,))
    d['w_uk'] = nrm((KV_LORA, MLA_HEADS * QK_NOPE), KV_LORA ** -0.5)
    d['w_uv'] = nrm((KV_LORA, MLA_HEADS * V_HEAD), KV_LORA ** -0.5)
    d['g_k_nope'] = gain((QK_NOPE,))
    d['g_k_rope'] = gain((QK_ROPE // 2,))
    return d


def reference(x_prompt, x_sample, cache_kv, state_pool, cache_mem_k, cache_mem_v, page_table, mem_prompt,
              norm_mix, norm_ffn, w_out, w_ffn_in, w_ffn_out, norm_mem, w_mem_kv, g_mem_q, g_mem_k,
              w_in_a, w_pool_grp, pool_scale, w_in_b, g_q_lora, w_uq, g_q,
              norm_kv, w_dkv, g_kv_lora, w_uk, w_uv, g_k_nope, g_k_rope):
    p = dict(norm_mix=norm_mix, norm_ffn=norm_ffn, w_out=w_out, w_ffn_in=w_ffn_in, w_ffn_out=w_ffn_out,
             g_mem_q=g_mem_q, w_in_a=w_in_a, w_pool_grp=w_pool_grp, pool_scale=pool_scale,
             w_in_b=w_in_b, g_q_lora=g_q_lora, w_uq=w_uq, g_q=g_q, norm_kv=norm_kv, w_dkv=w_dkv,
             g_kv_lora=g_kv_lora, w_uk=w_uk, w_uv=w_uv, g_k_nope=g_k_nope, g_k_rope=g_k_rope)
    b_p, s_p, _ = x_prompt.shape
    pos_p = jnp.arange(s_p)
    mem_k_prompt, mem_v_prompt = memory_kv(mem_prompt, norm_mem, w_mem_kv, g_mem_k)
    pool0 = jnp.zeros((N_A_LAYERS, b_p, POOL_STATE, POOL_W), x_prompt.dtype)
    y_prompt, kv_prompt, pool_prompt = trunk(x_prompt, pos_p, pool0, mem_k_prompt, mem_v_prompt, None, p)
    n_seq, n_pages = page_table.shape
    past_len = n_pages * cache_kv.shape[1]
    kv_past = cache_kv[page_table].reshape(n_seq, past_len, KV_ROW)
    pos_s = past_len + jnp.arange(x_sample.shape[1])
    y_sample, kv_sample, pool_sample = trunk(x_sample, pos_s, state_pool, cache_mem_k, cache_mem_v, kv_past, p)
    return (y_prompt, y_sample, kv_prompt, kv_sample, pool_prompt, pool_sample, mem_k_prompt, mem_v_prompt)
```

```cpp
#include <hip/hip_runtime.h>
#include <stdint.h>
#include <stddef.h>
namespace nv {

template <bool TB>
__global__ __launch_bounds__(256) void sgemm_k(const float* __restrict__ A, const float* __restrict__ B, float* __restrict__ C,
                                               int M, int N, int K, int lda, int ldb, int ldc,
                                               long sA1, long sB1, long sC1, int nb2, long sA2, long sB2, long sC2, int causal) {
    __shared__ __attribute__((aligned(16))) float As[16][68];
    __shared__ __attribute__((aligned(16))) float Bs[16][68];
    const int z = blockIdx.z, b1 = z / nb2, b2 = z % nb2;
    A += (long)b1 * sA1 + (long)b2 * sA2; B += (long)b1 * sB1 + (long)b2 * sB2; C += (long)b1 * sC1 + (long)b2 * sC2;
    const int tid = threadIdx.x, tx = tid & 15, ty = tid >> 4;
    const int m0 = blockIdx.y * 64, n0 = blockIdx.x * 64;
    int Kend = K;
    if (causal == 1) { if (n0 > m0 + 63) return; }
    if (causal == 2) { Kend = (m0 + 64 < K) ? (m0 + 64) : K; }
    float acc[4][4];
#pragma unroll
    for (int i = 0; i < 4; ++i)
#pragma unroll
        for (int j = 0; j < 4; ++j) acc[i][j] = 0.f;
    for (int k0 = 0; k0 < Kend; k0 += 16) {
#pragma unroll
        for (int i = 0; i < 4; ++i) {
            const int idx = tid + i * 256;
            { const int r = idx >> 4, kk = idx & 15; const int gm = m0 + r, gk = k0 + kk;
              As[kk][r] = (gm < M && gk < Kend) ? A[(long)gm * lda + gk] : 0.f; }
            if (TB) { const int c = idx >> 4, kk = idx & 15; const int gn = n0 + c, gk = k0 + kk;
                      Bs[kk][c] = (gn < N && gk < Kend) ? B[(long)gn * ldb + gk] : 0.f; }
            else    { const int kk = idx >> 6, c = idx & 63; const int gn = n0 + c, gk = k0 + kk;
                      Bs[kk][c] = (gn < N && gk < Kend) ? B[(long)gk * ldb + gn] : 0.f; }
        }
        __syncthreads();
#pragma unroll
        for (int kk = 0; kk < 16; ++kk) {
            const float4 a = *(const float4*)&As[kk][ty * 4];
            const float4 b = *(const float4*)&Bs[kk][tx * 4];
            const float av[4] = {a.x, a.y, a.z, a.w}, bv[4] = {b.x, b.y, b.z, b.w};
#pragma unroll
            for (int i = 0; i < 4; ++i)
#pragma unroll
                for (int j = 0; j < 4; ++j) acc[i][j] += av[i] * bv[j];
        }
        __syncthreads();
    }
#pragma unroll
    for (int i = 0; i < 4; ++i) {
        const int gm = m0 + ty * 4 + i; if (gm >= M) continue;
#pragma unroll
        for (int j = 0; j < 4; ++j) { const int gn = n0 + tx * 4 + j; if (gn < N) C[(long)gm * ldc + gn] = acc[i][j]; }
    }
}

struct GemmArgs { const float* A; const float* B; float* C; int M, N, K, lda, ldb, ldc; long sA1 = 0, sB1 = 0, sC1 = 0; int nb1 = 1, nb2 = 1; long sA2 = 0, sB2 = 0, sC2 = 0; int causal = 0; bool tb = false; };
static void sgemm(hipStream_t st, const GemmArgs& g) {
    dim3 grid((g.N + 63) / 64, (g.M + 63) / 64, g.nb1 * g.nb2);
    if (g.tb) hipLaunchKernelGGL((sgemm_k<true>), grid, dim3(256), 0, st, g.A, g.B, g.C, g.M, g.N, g.K, g.lda, g.ldb, g.ldc, g.sA1, g.sB1, g.sC1, g.nb2, g.sA2, g.sB2, g.sC2, g.causal);
    else      hipLaunchKernelGGL((sgemm_k<false>), grid, dim3(256), 0, st, g.A, g.B, g.C, g.M, g.N, g.K, g.lda, g.ldb, g.ldc, g.sA1, g.sB1, g.sC1, g.nb2, g.sA2, g.sB2, g.sC2, g.causal);
}

__device__ __forceinline__ float wave_sum(float v) {
#pragma unroll
    for (int o = 32; o >= 1; o >>= 1) v += __shfl_xor(v, o);
    return v;
}
__device__ __forceinline__ float wave_max(float v) {
#pragma unroll
    for (int o = 32; o >= 1; o >>= 1) v = fmaxf(v, __shfl_xor(v, o));
    return v;
}

__global__ void rmsnorm_k(const float* __restrict__ in, float* __restrict__ out, const float* __restrict__ gain,
                          long rows, int nh, int Dh, long ld_in, long ld_out) {
    const long nw = (long)gridDim.x * (blockDim.x >> 6); const int lane = threadIdx.x & 63;
    for (long it = (long)blockIdx.x * (blockDim.x >> 6) + (threadIdx.x >> 6); it < rows * nh; it += nw) {
        const long r = it / nh; const int h = (int)(it % nh);
        const float* s = in + r * ld_in + (long)h * Dh; float* d = out + r * ld_out + (long)h * Dh;
        float ss = 0.f; for (int i = lane; i < Dh; i += 64) { const float v = s[i]; ss += v * v; }
        ss = wave_sum(ss);
        const float sc = rsqrtf(ss / (float)Dh + 1e-6f);
        for (int i = lane; i < Dh; i += 64) d[i] = s[i] * sc * (gain ? gain[i] : 1.f);
    }
}

__global__ void concat_x_k(const float* __restrict__ xp, const float* __restrict__ xs, float* __restrict__ X, long np, long ns) {
    for (long i = (long)blockIdx.x * blockDim.x + threadIdx.x; i < np + ns; i += (long)gridDim.x * blockDim.x) X[i] = i < np ? xp[i] : xs[i - np];
}
__global__ void add_k(float* __restrict__ X, const float* __restrict__ T, long n) {
    for (long i = (long)blockIdx.x * blockDim.x + threadIdx.x; i < n; i += (long)gridDim.x * blockDim.x) X[i] += T[i];
}
__global__ void copy2d_k(const float* __restrict__ in, float* __restrict__ out, long rows, int cols, long ld_in, long ld_out) {
    for (long i = (long)blockIdx.x * blockDim.x + threadIdx.x; i < rows * cols; i += (long)gridDim.x * blockDim.x) { const long r = i / cols; const int c = (int)(i % cols); out[r * ld_out + c] = in[r * ld_in + c]; }
}
__global__ void scale_cols_k(float* __restrict__ X, const float* __restrict__ sc, long rows, int cols, long ld) {
    for (long i = (long)blockIdx.x * blockDim.x + threadIdx.x; i < rows * cols; i += (long)gridDim.x * blockDim.x) { const long r = i / cols; const int c = (int)(i % cols); X[r * ld + c] *= sc[c]; }
}
__global__ void silu_mul_k(const float* __restrict__ GU, float* __restrict__ ACT, long rows) {
    for (long i = (long)blockIdx.x * blockDim.x + threadIdx.x; i < rows * 2816; i += (long)gridDim.x * blockDim.x) { const long r = i / 2816; const int c = (int)(i % 2816);
        const float g = GU[r * 5632 + c], u = GU[r * 5632 + 2816 + c]; ACT[i] = g / (1.f + expf(-g)) * u; }
}

__global__ void poolprep_k(const float* __restrict__ PROJ, long ld, const float* __restrict__ prev, float* __restrict__ DIFF,
                           float* __restrict__ pool_p  , float* __restrict__ pool_s  ) {
    const long total = 16640L * 768;
    for (long i = (long)blockIdx.x * blockDim.x + threadIdx.x; i < total; i += (long)gridDim.x * blockDim.x) {
        const long r = i / 768; const int c = (int)(i % 768); const int g = c / 192, w = 2 << g;
        float sum = 0.f, cnt;
        if (r < 16384) { const int s = (int)(r & 2047);
            for (int j = 0; j < w; ++j) if (s - j >= 0) sum += PROJ[(r - j) * ld + c];
            cnt = (float)((s + 1 < w) ? (s + 1) : w);
            if (s >= 2033) pool_p[((r >> 11) * 15 + (s - 2033)) * 768 + c] = PROJ[r * ld + c];
        } else { const int q = (int)(r - 16384), b = q >> 3, t = q & 7;
            for (int j = 0; j < w; ++j) { const int tt = t - j; sum += (tt >= 0) ? PROJ[(r - j) * ld + c] : prev[((long)b * 15 + (15 + tt)) * 768 + c]; }
            cnt = (float)w;
            pool_s[((long)b * 15 + 7 + t) * 768 + c] = PROJ[r * ld + c];
            if (t < 7) pool_s[((long)b * 15 + t) * 768 + c] = prev[((long)b * 15 + t + 8) * 768 + c];
        }
        DIFF[r * 768 + c] = sum / cnt - PROJ[r * ld + c];
    }
}

__global__ void softmax256_k(float* __restrict__ S, long rows, float scale) {
    const long nw = (long)gridDim.x * (blockDim.x >> 6); const int lane = threadIdx.x & 63;
    for (long r = (long)blockIdx.x * (blockDim.x >> 6) + (threadIdx.x >> 6); r < rows; r += nw) {
        float* p = S + r * 256; float v[4]; float mx = -3e38f;
        for (int i = 0; i < 4; ++i) { v[i] = p[lane + 64 * i] * scale; mx = fmaxf(mx, v[i]); }
        mx = wave_max(mx); float sm = 0.f;
        for (int i = 0; i < 4; ++i) { v[i] = expf(v[i] - mx); sm += v[i]; }
        sm = wave_sum(sm); const float inv = 1.f / sm;
        for (int i = 0; i < 4; ++i) p[lane + 64 * i] = v[i] * inv;
    }
}

__global__ void kvrows_k(const float* __restrict__ CK, const float* __restrict__ gkv, float* __restrict__ KV) {
    const long nw = (long)gridDim.x * (blockDim.x >> 6); const int lane = threadIdx.x & 63;
    for (long r = (long)blockIdx.x * (blockDim.x >> 6) + (threadIdx.x >> 6); r < 16640; r += nw) {
        const float* s = CK + r * 288; float* d = KV + r * 288;
        float ss = 0.f; for (int i = lane; i < 256; i += 64) ss += s[i] * s[i];
        ss = wave_sum(ss); const float sc = rsqrtf(ss / 256.f + 1e-6f);
        for (int i = lane; i < 256; i += 64) d[i] = s[i] * sc * gkv[i];
        const float pos = (r < 16384) ? (float)(r & 2047) : (float)(16384 + ((r - 16384) & 7));
        if (lane < 16) { const float inv_freq = powf(10000.f, -(float)lane / 16.f); const float ang = pos * inv_freq; const float cs = cosf(ang), sn = sinf(ang);
            const float x1 = s[256 + lane], x2 = s[272 + lane]; d[256 + lane] = x1 * cs - x2 * sn; d[272 + lane] = x1 * sn + x2 * cs; }
    }
}

__global__ void gather_kv_k(const float* __restrict__ cache, const int* __restrict__ pt, const float* __restrict__ kv_s  , float* __restrict__ KVS) {
    const long total = 32L * 16392 * 72;
    for (long i = (long)blockIdx.x * blockDim.x + threadIdx.x; i < total; i += (long)gridDim.x * blockDim.x) {
        const long row = i / 72; const int c4 = (int)(i % 72); const int b = (int)(row / 16392), k = (int)(row % 16392);
        const float4* src;
        if (k < 16384) { const int page = pt[b * 128 + (k >> 7)]; src = (const float4*)(cache + ((long)page * 128 + (k & 127)) * 288); }
        else src = (const float4*)(kv_s + ((long)b * 8 + (k - 16384)) * 288);
        ((float4*)KVS)[i] = src[c4];
    }
}

__global__ void kinv_k(const float* __restrict__ KN, const float* __restrict__ KVrows  , float* __restrict__ KINV, long rows) {
    const long nw = (long)gridDim.x * (blockDim.x >> 6); const int lane = threadIdx.x & 63;
    for (long r = (long)blockIdx.x * (blockDim.x >> 6) + (threadIdx.x >> 6); r < rows; r += nw) {
        float kr = (lane < 32) ? KVrows[r * 288 + 256 + lane] : 0.f; kr = wave_sum(kr * kr);
        for (int h = 0; h < 12; ++h) { const float v = KN[r * 768 + h * 64 + lane]; const float ss = wave_sum(v * v);
            if (lane == 0) KINV[r * 12 + h] = rsqrtf((ss + kr) / 96.f + 1e-6f); }
    }
}

__global__ void qpost_k(const float* __restrict__ Q, const float* __restrict__ gq, const float* __restrict__ gkn, const float* __restrict__ gkr,
                        float* __restrict__ QN, float* __restrict__ QFULL) {
    const long nw = (long)gridDim.x * (blockDim.x >> 6); const int lane = threadIdx.x & 63;
    for (long it = (long)blockIdx.x * (blockDim.x >> 6) + (threadIdx.x >> 6); it < 16640L * 12; it += nw) {
        const long r = it / 12; const int h = (int)(it % 12);
        const float* s = Q + r * 1152 + h * 96;
        const float a = s[lane], b = (lane < 32) ? s[64 + lane] : 0.f;
        const float ss = wave_sum(a * a + b * b); const float sc = rsqrtf(ss / 96.f + 1e-6f);
        QN[r * 768 + h * 64 + lane] = a * sc * gq[lane] * gkn[lane];
        const float pos = (r < 16384) ? (float)(r & 2047) : (float)(16384 + ((r - 16384) & 7));
        if (lane < 16) { const float x1 = s[64 + lane] * sc * gq[64 + lane], x2 = s[80 + lane] * sc * gq[80 + lane];
            const float inv_freq = powf(10000.f, -(float)lane / 16.f); const float ang = pos * inv_freq; const float cs = cosf(ang), sn = sinf(ang);
            QFULL[r * 3456 + h * 288 + 256 + lane] = (x1 * cs - x2 * sn) * gkr[lane];
            QFULL[r * 3456 + h * 288 + 272 + lane] = (x1 * sn + x2 * cs) * gkr[lane]; }
    }
}

__global__ void mla_softmax_k(float* __restrict__ SC, const float* __restrict__ KINV, int mode, long nrows) {
    const long nw = (long)gridDim.x * (blockDim.x >> 6); const int lane = threadIdx.x & 63;
    for (long row = (long)blockIdx.x * (blockDim.x >> 6) + (threadIdx.x >> 6); row < nrows; row += nw) {
        int h, qpos; long L; const float* ki;
        if (mode == 0) { h = (int)(row / 2048); qpos = (int)(row % 2048); L = 2048; ki = KINV; }
        else { const int b = (int)(row / 96), q = (int)(row % 96); h = q % 12; qpos = 16384 + q / 12; L = 16392; ki = KINV + (long)b * 16392 * 12; }
        float* p = SC + row * L; const float scl = 0.10206207261596577f;
        float mx = -3e38f;
        for (long k = lane; k <= qpos; k += 64) { const float v = p[k] * ki[k * 12 + h] * scl; p[k] = v; mx = fmaxf(mx, v); }
        mx = wave_max(mx); float sm = 0.f;
        for (long k = lane; k <= qpos; k += 64) { const float e = expf(p[k] - mx); p[k] = e; sm += e; }
        sm = wave_sum(sm); const float inv = 1.f / sm;
        for (long k = lane; k < L; k += 64) p[k] = (k <= qpos) ? p[k] * inv : 0.f;
    }
}

struct Bufs {
    float *H, *PROJ, *DIFF, *CAT, *T1, *GU, *ACT, *QMN, *SCM, *HML, *MKV, *CK, *KVS, *KN, *KINVP, *KINVS, *CQ, *Q, *QN, *QFULL, *SC, *OLAT;
    size_t total;
};
static Bufs carve(float* base) {
    Bufs b; size_t o = 0; auto take = [&](size_t n) { float* p = base + o; o += (n + 63) & ~(size_t)63; return p; };
    const size_t M = 16640;
    b.H = take(M * 1024); b.PROJ = take(M * 1024); b.DIFF = take(M * 768); b.CAT = take(M * 1024); b.T1 = take(M * 1024);
    b.GU = take(M * 5632); b.ACT = take(M * 2816); b.QMN = take(M * 256); b.SCM = take((size_t)(8 * 4 * 2048 + 32 * 4 * 8) * 256);
    b.HML = take((size_t)2048 * 1024); b.MKV = take((size_t)2048 * 512); b.CK = take(M * 288);
    b.KVS = take((size_t)32 * 16392 * 288); b.KN = take((size_t)16392 * 768); b.KINVP = take((size_t)16384 * 12); b.KINVS = take((size_t)32 * 16392 * 12);
    b.CQ = take(M * 384); b.Q = take(M * 1152); b.QN = take(M * 768); b.QFULL = take(M * 3456);
    b.SC = take((size_t)32 * 96 * 16392); b.OLAT = take(M * 3072);
    b.total = o; return b;
}

struct Outs { float *X, *KV, *pool_p, *pool_s, *mem_k, *mem_v; };

#define NV_EW(kern, ...) hipLaunchKernelGGL(kern, dim3(2048), dim3(256), 0, st, __VA_ARGS__)

static void forward(hipStream_t st, void* const* d_in, const Outs& o, const Bufs& w) {
    const float* x_prompt = (const float*)d_in[0]; const float* x_sample = (const float*)d_in[1]; const float* cache_kv = (const float*)d_in[2];
    const float* state_pool = (const float*)d_in[3]; const float* cache_mem_k = (const float*)d_in[4]; const float* cache_mem_v = (const float*)d_in[5];
    const int* page_table = (const int*)d_in[6]; const float* mem_prompt = (const float*)d_in[7];
    const float* norm_mix = (const float*)d_in[8]; const float* norm_ffn = (const float*)d_in[9]; const float* w_out = (const float*)d_in[10];
    const float* w_ffn_in = (const float*)d_in[11]; const float* w_ffn_out = (const float*)d_in[12]; const float* norm_mem = (const float*)d_in[13];
    const float* w_mem_kv = (const float*)d_in[14]; const float* g_mem_q = (const float*)d_in[15]; const float* g_mem_k = (const float*)d_in[16];
    const float* w_in_a = (const float*)d_in[17]; const float* w_pool_grp = (const float*)d_in[18]; const float* pool_scale = (const float*)d_in[19];
    const float* w_in_b = (const float*)d_in[20]; const float* g_q_lora = (const float*)d_in[21]; const float* w_uq = (const float*)d_in[22];
    const float* g_q = (const float*)d_in[23]; const float* norm_kv = (const float*)d_in[24]; const float* w_dkv = (const float*)d_in[25];
    const float* g_kv_lora = (const float*)d_in[26]; const float* w_uk = (const float*)d_in[27]; const float* w_uv = (const float*)d_in[28];
    const float* g_k_nope = (const float*)d_in[29]; const float* g_k_rope = (const float*)d_in[30];
    const int M = 16640, MP = 16384;

    NV_EW(concat_x_k, x_prompt, x_sample, o.X, (long)MP * 1024, 256L * 1024);
    for (int l = 0; l < 4; ++l) {
        NV_EW(rmsnorm_k, mem_prompt, w.HML, norm_mem + l * 1024, 2048L, 1, 1024, 1024L, 1024L);
        { GemmArgs g{w.HML, w_mem_kv + (size_t)l * 1024 * 512, w.MKV, 2048, 512, 1024, 1024, 512, 512}; sgemm(st, g); }
        NV_EW(rmsnorm_k, w.MKV, o.mem_k + (size_t)l * 2048 * 256, g_mem_k + l * 64, 2048L, 4, 64, 512L, 256L);
        NV_EW(copy2d_k, w.MKV + 256, o.mem_v + (size_t)l * 2048 * 256, 2048L, 256, 512L, 256L);
    }
    for (int l = 0; l < 4; ++l) {
        NV_EW(rmsnorm_k, o.X, w.H, norm_mix + l * 1024, (long)M, 1, 1024, 1024L, 1024L);
        int ldp, qm_off;
        if (l < 2) {
            ldp = 1024; qm_off = 768;
            { GemmArgs g{w.H, w_in_a + (size_t)l * 1024 * 1024, w.PROJ, M, 1024, 1024, 1024, 1024, 1024}; sgemm(st, g); }
            NV_EW(poolprep_k, w.PROJ, 1024L, state_pool + (size_t)l * 32 * 15 * 768, w.DIFF, o.pool_p + (size_t)l * 8 * 15 * 768, o.pool_s + (size_t)l * 32 * 15 * 768);
            { GemmArgs g{w.DIFF, w_pool_grp + (size_t)l * 4 * 192 * 192, w.CAT, M, 192, 192, 768, 192, 1024}; g.nb2 = 4; g.sA2 = 192; g.sB2 = 192 * 192; g.sC2 = 192; sgemm(st, g); }
            NV_EW(scale_cols_k, w.CAT, pool_scale + l * 768, (long)M, 768, 1024L);
        } else {
            const int j = l - 2; ldp = 640; qm_off = 384;
            if (j == 0) {
                NV_EW(rmsnorm_k, o.X, w.T1, norm_kv, (long)M, 1, 1024, 1024L, 1024L);
                { GemmArgs g{w.T1, w_dkv, w.CK, M, 288, 1024, 1024, 288, 288}; sgemm(st, g); }
                NV_EW(kvrows_k, w.CK, g_kv_lora, o.KV);
                NV_EW(gather_kv_k, cache_kv, page_table, o.KV + (size_t)MP * 288, w.KVS);
                { GemmArgs g{o.KV, w_uk, w.KN, MP, 768, 256, 288, 768, 768}; sgemm(st, g); }
                NV_EW(kinv_k, w.KN, o.KV, w.KINVP, (long)MP);
                for (int b = 0; b < 32; ++b) {
                    { GemmArgs g{w.KVS + (size_t)b * 16392 * 288, w_uk, w.KN, 16392, 768, 256, 288, 768, 768}; sgemm(st, g); }
                    NV_EW(kinv_k, w.KN, w.KVS + (size_t)b * 16392 * 288, w.KINVS + (size_t)b * 16392 * 12, 16392L);
                }
            }
            { GemmArgs g{w.H, w_in_b + (size_t)j * 1024 * 640, w.PROJ, M, 640, 1024, 1024, 640, 640}; sgemm(st, g); }
            NV_EW(rmsnorm_k, w.PROJ, w.CQ, g_q_lora + j * 384, (long)M, 1, 384, 640L, 384L);
            { GemmArgs g{w.CQ, w_uq + (size_t)j * 384 * 1152, w.Q, M, 1152, 384, 384, 1152, 1152}; sgemm(st, g); }
            NV_EW(qpost_k, w.Q, g_q + j * 96, g_k_nope, g_k_rope, w.QN, w.QFULL);
            { GemmArgs g{w.QN, w_uk, w.QFULL, M, 256, 64, 768, 768, 3456}; g.tb = true; g.nb2 = 12; g.sA2 = 64; g.sB2 = 64; g.sC2 = 288; sgemm(st, g); }
            for (int b = 0; b < 8; ++b) {
                { GemmArgs g{w.QFULL + (size_t)b * 2048 * 3456, o.KV + (size_t)b * 2048 * 288, w.SC, 2048, 2048, 288, 3456, 288, 2048}; g.tb = true; g.nb2 = 12; g.sA2 = 288; g.sB2 = 0; g.sC2 = 2048L * 2048; g.causal = 1; sgemm(st, g); }
                NV_EW(mla_softmax_k, w.SC, w.KINVP + (size_t)b * 2048 * 12, 0, 12L * 2048);
                { GemmArgs g{w.SC, o.KV + (size_t)b * 2048 * 288, w.OLAT + (size_t)b * 2048 * 3072, 2048, 256, 2048, 2048, 288, 3072}; g.nb2 = 12; g.sA2 = 2048L * 2048; g.sB2 = 0; g.sC2 = 256; g.causal = 2; sgemm(st, g); }
            }
            { GemmArgs g{w.QFULL + (size_t)MP * 3456, w.KVS, w.SC, 96, 16392, 288, 288, 288, 16392}; g.tb = true; g.nb1 = 32; g.sA1 = 96L * 288; g.sB1 = 16392L * 288; g.sC1 = 96L * 16392; sgemm(st, g); }
            NV_EW(mla_softmax_k, w.SC, w.KINVS, 1, 32L * 96);
            { GemmArgs g{w.SC, w.KVS, w.OLAT + (size_t)MP * 3072, 96, 256, 16392, 16392, 288, 256}; g.nb1 = 32; g.sA1 = 96L * 16392; g.sB1 = 16392L * 288; g.sC1 = 96L * 256; sgemm(st, g); }
            { GemmArgs g{w.OLAT, w_uv, w.CAT, M, 64, 256, 3072, 768, 1024}; g.nb2 = 12; g.sA2 = 256; g.sB2 = 64; g.sC2 = 64; sgemm(st, g); }
        }
        NV_EW(rmsnorm_k, w.PROJ + qm_off, w.QMN, g_mem_q + l * 64, (long)M, 4, 64, (long)ldp, 256L);
        { GemmArgs g{w.QMN, o.mem_k + (size_t)l * 2048 * 256, w.SCM, 2048, 256, 64, 256, 256, 256}; g.tb = true; g.nb1 = 8; g.nb2 = 4; g.sA1 = 2048L * 256; g.sB1 = 256L * 256; g.sC1 = 4L * 2048 * 256; g.sA2 = 64; g.sB2 = 64; g.sC2 = 2048L * 256; sgemm(st, g); }
        { GemmArgs g{w.QMN + (size_t)MP * 256, cache_mem_k + (size_t)l * 32 * 65536, w.SCM + (size_t)8 * 4 * 2048 * 256, 8, 256, 64, 256, 256, 256}; g.tb = true; g.nb1 = 32; g.nb2 = 4; g.sA1 = 8L * 256; g.sB1 = 65536; g.sC1 = 4L * 8 * 256; g.sA2 = 64; g.sB2 = 64; g.sC2 = 8L * 256; sgemm(st, g); }
        NV_EW(softmax256_k, w.SCM, (long)(8 * 4 * 2048 + 32 * 4 * 8), 0.125f);
        { GemmArgs g{w.SCM, o.mem_v + (size_t)l * 2048 * 256, w.CAT + 768, 2048, 64, 256, 256, 256, 1024}; g.nb1 = 8; g.nb2 = 4; g.sA1 = 4L * 2048 * 256; g.sB1 = 65536; g.sC1 = 2048L * 1024; g.sA2 = 2048L * 256; g.sB2 = 64; g.sC2 = 64; sgemm(st, g); }
        { GemmArgs g{w.SCM + (size_t)8 * 4 * 2048 * 256, cache_mem_v + (size_t)l * 32 * 65536, w.CAT + (size_t)MP * 1024 + 768, 8, 64, 256, 256, 256, 1024}; g.nb1 = 32; g.nb2 = 4; g.sA1 = 4L * 8 * 256; g.sB1 = 65536; g.sC1 = 8L * 1024; g.sA2 = 8L * 256; g.sB2 = 64; g.sC2 = 64; sgemm(st, g); }
        { GemmArgs g{w.CAT, w_out + (size_t)l * 1024 * 1024, w.T1, M, 1024, 1024, 1024, 1024, 1024}; sgemm(st, g); }
        NV_EW(add_k, o.X, w.T1, (long)M * 1024);
        NV_EW(rmsnorm_k, o.X, w.H, norm_ffn + l * 1024, (long)M, 1, 1024, 1024L, 1024L);
        { GemmArgs g{w.H, w_ffn_in + (size_t)l * 1024 * 5632, w.GU, M, 5632, 1024, 1024, 5632, 5632}; sgemm(st, g); }
        NV_EW(silu_mul_k, w.GU, w.ACT, (long)M);
        { GemmArgs g{w.ACT, w_ffn_out + (size_t)l * 2816 * 1024, w.T1, M, 1024, 2816, 2816, 1024, 1024}; sgemm(st, g); }
        NV_EW(add_k, o.X, w.T1, (long)M * 1024);
    }
}
}
extern "C" void kernel_launch(void* const* d_in, const int* in_sizes, int n_in,
                              void* d_out, int out_size, void* d_ws, size_t ws_size,
                              hipStream_t stream) {
    float* out = (float*)d_out;
    nv::Outs o; o.X = out; o.KV = out + 17039360; o.pool_p = out + 21831680; o.pool_s = out + 22016000; o.mem_k = out + 22753280; o.mem_v = out + 24850432;
    nv::Bufs w = nv::carve((float*)d_ws);
    if (w.total * sizeof(float) > ws_size) return;
    nv::forward(stream, d_in, o, w);
}
```

```cpp
#include <hip/hip_runtime.h>
#include <stdint.h>
#include <stddef.h>
namespace fk {
#define LAS __attribute__((address_space(3)))
typedef unsigned short bf16_t;
typedef short bf16x8 __attribute__((ext_vector_type(8)));
typedef short s16x4 __attribute__((ext_vector_type(4)));
typedef float f32x4 __attribute__((ext_vector_type(4)));
typedef float f32x16 __attribute__((ext_vector_type(16)));
typedef unsigned u32x4 __attribute__((ext_vector_type(4)));
typedef unsigned u32x2 __attribute__((ext_vector_type(2)));

constexpr int MP = 16384, MS = 256, MT = 16640;
constexpr int NTHR = 512;
constexpr float EPSF = 1e-6f;

typedef float f32x2_t __attribute__((ext_vector_type(2)));
typedef __bf16 bf16x2_t __attribute__((ext_vector_type(2)));
__device__ __forceinline__ unsigned pk2(float lo, float hi) { f32x2_t v = {lo, hi}; bf16x2_t b = __builtin_convertvector(v, bf16x2_t); return __builtin_bit_cast(unsigned, b); }
__device__ __forceinline__ unsigned f2bf(float f) { return pk2(f, 0.f) & 0xffffu; }
__device__ __forceinline__ int opaque_tid() { int t = threadIdx.x; asm volatile("" : "+v"(t)); return t; }
__device__ __forceinline__ float bf2f(unsigned short b) { return __builtin_bit_cast(float, ((unsigned)b) << 16); }
__device__ __forceinline__ float bflo(unsigned w) { return __builtin_bit_cast(float, w << 16); }
__device__ __forceinline__ float bfhi(unsigned w) { return __builtin_bit_cast(float, w & 0xffff0000u); }
__device__ __forceinline__ float wsum(float v) {
#pragma unroll
    for (int o = 32; o >= 1; o >>= 1) v += __shfl_xor(v, o);
    return v;
}
__device__ __forceinline__ float wmax(float v) {
#pragma unroll
    for (int o = 32; o >= 1; o >>= 1) v = fmaxf(v, __shfl_xor(v, o));
    return v;
}
__device__ __forceinline__ int rope_idx(int r) { return r < MP ? (r & 2047) : 2048 + ((r - MP) & 7); }

__host__ __device__ __forceinline__ int slot_of_logical(int L) { const int wc = L >> 6, bj = (L >> 5) & 1, fq = (L >> 3) & 3, n = (L >> 2) & 1, j = L & 3; return 128 * bj + 32 * wc + 16 * n + 4 * fq + j; }

struct P {
    const float *x_prompt, *x_sample, *cache_kv, *state_pool, *cache_mem_k, *cache_mem_v; const int* page_table; const float* mem_prompt;
    const float *norm_mix, *norm_ffn, *w_out, *w_ffn_in, *w_ffn_out, *norm_mem, *w_mem_kv, *g_mem_q, *g_mem_k, *w_in_a, *w_pool_grp, *pool_scale,
                *w_in_b, *g_q_lora, *w_uq, *g_q, *norm_kv, *w_dkv, *g_kv_lora, *w_uk, *w_uv, *g_k_nope, *g_k_rope;
    float *X  , *KVO  , *pool_p, *pool_s, *mem_k, *mem_v;
    bf16_t *BT_A1, *BT_OUT, *BT_F1, *BT_F2, *BT_B1, *BT_UQ, *BT_KV, *BT_MEM, *BT_MIX;
    bf16_t *XB, *U, *QM, *DIFF, *CAT, *ACT, *CQ, *KVB, *QF, *KF, *VF, *HM, *MKB, *MVB, *MKS, *MVS, *KVBS, *WUKB;
    float *SSQ  , *SSQCQ  , *SSQQ  , *CK  , *KINV  , *KINVS  , *ROPEC, *ROPES  ;
    float *OPART  , *MLPART  ;
    unsigned *bar, *ctl;
};
}
namespace fk {
constexpr int BM = 256, BK = 64, HALF = 128, HTB = HALF * BK * 2, STAGE_BYTES = 8 * HTB, NXCD = 8, WGM = 8;
__host__ __device__ __forceinline__ int lds_byte(int r, int c) { const int st = (r >> 4) * 2 + (c >> 5), rr = r & 15, cc = c & 31, ob = rr * 64 + cc * 2; return st * 1024 + (ob ^ (((ob >> 9) & 1) << 5)); }
__host__ __device__ __forceinline__ void stage_rc(int b, int& R, int& C) { const int st = b / 1024, sb = b % 1024, swz = sb ^ (((sb >> 9) & 1) << 5); R = (st >> 1) * 16 + swz / 64; C = (st & 1) * 32 + (swz % 64) / 2; }

struct Unit { int pm, pn; };
struct Gemm { const bf16_t* A; const bf16_t* Bt; int nM, nN, K, lda, ldb, a_pn_off; };

struct StaticOrder {
    int nM, nN, nwg, G, c;
    __device__ void init(int nM_, int nN_, int G_, int c_) { nM = nM_; nN = nN_; nwg = nM * nN; G = G_; c = c_; }
    __device__ bool next(int i, Unit& u) const {
        const long L = (long)i * G + c; if (L >= nwg) return false;
        int wgid = (int)L; { const int q = nwg / NXCD, r = nwg % NXCD, xcd = wgid % NXCD, off = wgid / NXCD; wgid = (xcd < r ? xcd * (q + 1) : r * (q + 1) + (xcd - r) * q) + off; }
        const int nig = WGM * nN, gid = wgid / nig, fm = gid * WGM, gsz = (nM - fm) < WGM ? (nM - fm) : WGM;
        u.pm = fm + ((wgid % nig) % gsz); u.pn = (wgid % nig) / gsz; return true;
    }
};

typedef f32x4 Acc[2][2][4][2];

template <class Epi>
__device__ __forceinline__ void gemm_phase(LAS unsigned char* lds, const Gemm g, const Epi& E, int G, int c) {
    const int tid = opaque_tid(), wid = __builtin_amdgcn_readfirstlane(tid >> 6), lane = tid & 63, wr = wid >> 2, wc = wid & 3, fr = lane & 15, fq = lane >> 4;
    const int K = g.K, nt = K / BK;
    StaticOrder S; S.init(g.nM, g.nN, G, c);
    unsigned voffA[2], voffB[2];
#pragma unroll
    for (int i = 0; i < 2; ++i) { int R, C; stage_rc(tid * 16 + i * 8192, R, C); voffA[i] = (unsigned)(R * g.lda + C) * 2u; voffB[i] = (unsigned)(R * g.ldb + C) * 2u; }
    const size_t kstep = (size_t)(BK * 2);
    const size_t hstepA = (size_t)HALF * g.lda * 2, hstepB = (size_t)HALF * g.ldb * 2;
    const size_t tstepA = 2 * hstepA, tstepB = 2 * hstepB;
    const size_t apn = (size_t)g.a_pn_off * 2;
    const unsigned ldsw = (unsigned)wid * 1024u;
    const int aoff = lds_byte(wr * 64 + fr, fq * 8), boff = lds_byte(wc * 32 + fr, fq * 8);
#define PG8_SA(b, h) (((b) * 2 + (h)) * HTB)
#define PG8_SB(b, h) ((4 + (b) * 2 + (h)) * HTB)
#define PG8_STAGE(bufoff, gbase, voff) do { _Pragma("unroll") for (int _i = 0; _i < 2; ++_i) \
        __builtin_amdgcn_global_load_lds((const unsigned*)((const char*)(gbase) + (voff)[_i]), (LAS unsigned*)(lds + (bufoff) + ldsw + _i * 8192), 16, 0, 0); } while (0)
#define PG8_LDA(dst, b, h) do { _Pragma("unroll") for (int m = 0; m < 4; ++m) _Pragma("unroll") for (int k = 0; k < 2; ++k) dst[m][k] = *(const LAS bf16x8*)(lds + PG8_SA(b, h) + aoff + m * 2048 + k * 1024); } while (0)
#define PG8_LDB(dst, b, h) do { _Pragma("unroll") for (int n = 0; n < 2; ++n) _Pragma("unroll") for (int k = 0; k < 2; ++k) dst[n][k] = *(const LAS bf16x8*)(lds + PG8_SB(b, h) + boff + n * 2048 + k * 1024); } while (0)
#define PG8_MMA(ai, bj, At, Bt) do { __builtin_amdgcn_s_setprio(1); _Pragma("unroll") for (int m = 0; m < 4; ++m) _Pragma("unroll") for (int n = 0; n < 2; ++n) _Pragma("unroll") for (int k = 0; k < 2; ++k) \
        acc[ai][bj][m][n] = __builtin_amdgcn_mfma_f32_16x16x32_bf16(Bt[n][k], At[m][k], acc[ai][bj][m][n], 0, 0, 0); __builtin_amdgcn_s_setprio(0); } while (0)
#define PG8_WAIT_V(n) asm volatile("s_waitcnt vmcnt(" #n ")" ::: "memory")
#define PG8_WAIT_L(n) asm volatile("s_waitcnt lgkmcnt(" #n ")" ::: "memory")
#define PG8_BAR __builtin_amdgcn_s_barrier()
#define PG8_SCHED __builtin_amdgcn_sched_barrier(0)
    Unit cur, nxt; int ui = 0;
    if (!S.next(0, cur)) return;
    Acc acc;
#pragma unroll
    for (int a = 0; a < 2; ++a)
#pragma unroll
        for (int b = 0; b < 2; ++b)
#pragma unroll
            for (int m = 0; m < 4; ++m)
#pragma unroll
                for (int n = 0; n < 2; ++n) acc[a][b][m][n] = (f32x4){0.f, 0.f, 0.f, 0.f};
    bf16x8 At[4][2], B0[2][2], B1[2][2];
    const char* cA = (const char*)g.A + (size_t)cur.pm * tstepA + (size_t)cur.pn * apn; const char* cB = (const char*)g.Bt + (size_t)cur.pn * tstepB;
    PG8_STAGE(PG8_SB(0, 0), cB, voffB); PG8_STAGE(PG8_SA(0, 0), cA, voffA); PG8_STAGE(PG8_SB(0, 1), cB + hstepB, voffB); PG8_STAGE(PG8_SA(0, 1), cA + hstepA, voffA);
    if (wr == 1) PG8_BAR;
    PG8_WAIT_V(4); PG8_BAR;
    PG8_STAGE(PG8_SB(1, 0), cB + kstep, voffB); PG8_STAGE(PG8_SA(1, 0), cA + kstep, voffA); PG8_STAGE(PG8_SB(1, 1), cB + hstepB + kstep, voffB);
    PG8_WAIT_V(6); PG8_BAR;
    for (;;) {
        const bool has_next = S.next(ui + 1, nxt);
        const char* nA = has_next ? (const char*)g.A + (size_t)nxt.pm * tstepA + (size_t)nxt.pn * apn : cA; const char* nB = has_next ? (const char*)g.Bt + (size_t)nxt.pn * tstepB : cB;
        for (int t = 0; t < nt; t += 2) {
            const bool last = (t == nt - 2);
            const char* a1 = cA + (size_t)(t + 1) * kstep;
            const char* a2 = last ? nA : cA + (size_t)(t + 2) * kstep; const char* b2 = last ? nB : cB + (size_t)(t + 2) * kstep;
            const char* a3 = a2 + kstep; const char* b3 = b2 + kstep;
            PG8_LDB(B0, 0, 0); PG8_SCHED; PG8_LDA(At, 0, 0); PG8_STAGE(PG8_SA(1, 1), a1 + hstepA, voffA);
            PG8_WAIT_L(8); PG8_BAR; PG8_WAIT_L(0); PG8_MMA(0, 0, At, B0); PG8_BAR; PG8_SCHED;
            PG8_LDB(B1, 0, 1); PG8_STAGE(PG8_SB(0, 0), b2, voffB);
            PG8_BAR; PG8_WAIT_L(0); PG8_MMA(0, 1, At, B1); PG8_BAR;
            PG8_LDA(At, 0, 1); PG8_STAGE(PG8_SA(0, 0), a2, voffA);
            PG8_BAR; PG8_WAIT_L(0); PG8_MMA(1, 0, At, B0); PG8_BAR; PG8_SCHED;
            PG8_STAGE(PG8_SB(0, 1), b2 + hstepB, voffB);
            PG8_WAIT_V(6); PG8_BAR; PG8_MMA(1, 1, At, B1); PG8_BAR;
            PG8_LDB(B0, 1, 0); PG8_SCHED; PG8_LDA(At, 1, 0); PG8_STAGE(PG8_SA(0, 1), a2 + hstepA, voffA);
            PG8_WAIT_L(8); PG8_BAR; PG8_WAIT_L(0); PG8_MMA(0, 0, At, B0); PG8_BAR; PG8_SCHED;
            PG8_LDB(B1, 1, 1); PG8_STAGE(PG8_SB(1, 0), b3, voffB);
            PG8_BAR; PG8_WAIT_L(0); PG8_MMA(0, 1, At, B1); PG8_BAR;
            PG8_LDA(At, 1, 1); PG8_STAGE(PG8_SA(1, 0), a3, voffA);
            PG8_BAR; PG8_WAIT_L(0); PG8_MMA(1, 0, At, B0); PG8_BAR; PG8_SCHED;
            PG8_STAGE(PG8_SB(1, 1), b3 + hstepB, voffB);
            PG8_WAIT_V(6); PG8_BAR; PG8_MMA(1, 1, At, B1); PG8_BAR;
        }
        {
          int tz = threadIdx.x; asm volatile("" : "+v"(tz)); const int wid2 = __builtin_amdgcn_readfirstlane(tz >> 6), lane2 = tz & 63;
          E(acc, cur, wid2 >> 2, wid2 & 3, lane2 & 15, lane2 >> 4); }
        if (!has_next) break;
#pragma unroll
        for (int a = 0; a < 2; ++a)
#pragma unroll
            for (int b = 0; b < 2; ++b)
#pragma unroll
                for (int m = 0; m < 4; ++m)
#pragma unroll
                    for (int n = 0; n < 2; ++n) acc[a][b][m][n] = (f32x4){0.f, 0.f, 0.f, 0.f};
        cur = nxt; cA = nA; cB = nB; ++ui;
    }
    PG8_WAIT_V(0);
    if (wr == 0) PG8_BAR;
    PG8_BAR;
#undef PG8_SA
#undef PG8_SB
#undef PG8_STAGE
#undef PG8_LDA
#undef PG8_LDB
#undef PG8_MMA
#undef PG8_WAIT_V
#undef PG8_WAIT_L
#undef PG8_BAR
#undef PG8_SCHED
}

#define EPI_ROWS(ai, m) (u.pm * BM + (ai) * HALF + wr * 64 + (m) * 16 + fr)
__device__ __forceinline__ void st_bf16x8(bf16_t* p, const f32x4& a, const f32x4& b) { u32x4 w; w.x = pk2(a[0], a[1]); w.y = pk2(a[2], a[3]); w.z = pk2(b[0], b[1]); w.w = pk2(b[2], b[3]); *(u32x4*)p = w; }
__device__ __forceinline__ float sq4(const f32x4& a) { return (a[0] * a[0] + a[1] * a[1]) + (a[2] * a[2] + a[3] * a[3]); }
__device__ __forceinline__ float fq_sum(float v) { v += __shfl_xor(v, 16); v += __shfl_xor(v, 32); return v; }
constexpr float QM_FOLD = 0.125f * 1.4426950408889634f;

__device__ __forceinline__ void qm_head_store(const Acc& acc, int ai, int m, float inv, const float* gq, bf16_t* dst  , int fq) {
    f32x4 v[2][2]; float ss = 0.f;
#pragma unroll
    for (int bj = 0; bj < 2; ++bj)
#pragma unroll
        for (int n = 0; n < 2; ++n) { v[bj][n] = acc[ai][bj][m][n] * inv; ss += sq4(v[bj][n]); }
    ss = fq_sum(ss);
    const float sc = rsqrtf(ss * (1.f / 64.f) + EPSF) * QM_FOLD;
#pragma unroll
    for (int bj = 0; bj < 2; ++bj) { const int d0 = 32 * bj + 8 * fq; const f32x4 g0 = *(const f32x4*)(gq + d0), g1 = *(const f32x4*)(gq + d0 + 4);
        st_bf16x8(dst + d0, v[bj][0] * sc * g0, v[bj][1] * sc * g1); }
}

struct EpiInA {
    const float* ssq; bf16_t* U; bf16_t* QM; const float* gq; float* pool_p; float* pool_s;
    __device__ __forceinline__ void operator()(const Acc& acc, const Unit& u, int wr, int wc, int fr, int fq) const {
#pragma unroll
        for (int ai = 0; ai < 2; ++ai)
#pragma unroll
            for (int m = 0; m < 4; ++m) { const int r = EPI_ROWS(ai, m); const float inv = rsqrtf(ssq[r] * (1.f / 1024.f) + EPSF);
                if (u.pn < 3) {
                    float* pst = nullptr;
                    if (r < MP) { const int s = r & 2047; if (s >= 2033) pst = pool_p + ((size_t)(r >> 11) * 15 + (s - 2033)) * 768; }
                    else { const int q = r - MP; pst = pool_s + ((size_t)(q >> 3) * 15 + 7 + (q & 7)) * 768; }
#pragma unroll
                    for (int bj = 0; bj < 2; ++bj) { const int c0 = u.pn * 256 + 64 * wc + 32 * bj + 8 * fq; const f32x4 a = acc[ai][bj][m][0] * inv, b = acc[ai][bj][m][1] * inv;
                        st_bf16x8(U + (size_t)r * 768 + c0, a, b);
                        if (pst) { *(f32x4*)(pst + c0) = a; *(f32x4*)(pst + c0 + 4) = b; } }
                } else qm_head_store(acc, ai, m, inv, gq, QM + (size_t)r * 256 + wc * 64, fq);
            }
    }
};

struct EpiPlainBf16 {
    bf16_t* O; int ldo;
    __device__ __forceinline__ void operator()(const Acc& acc, const Unit& u, int wr, int wc, int fr, int fq) const {
#pragma unroll
        for (int ai = 0; ai < 2; ++ai)
#pragma unroll
            for (int m = 0; m < 4; ++m) { const int r = EPI_ROWS(ai, m);
#pragma unroll
                for (int bj = 0; bj < 2; ++bj) { const int c0 = u.pn * 256 + 64 * wc + 32 * bj + 8 * fq; st_bf16x8(O + (size_t)r * ldo + c0, acc[ai][bj][m][0], acc[ai][bj][m][1]); } }
    }
};

struct EpiRes {
    float* X; bf16_t* XB; float* ssq_next;
    __device__ __forceinline__ void operator()(const Acc& acc, const Unit& u, int wr, int wc, int fr, int fq) const {
#pragma unroll
        for (int ai = 0; ai < 2; ++ai)
#pragma unroll
            for (int m = 0; m < 4; ++m) { const int r = EPI_ROWS(ai, m); float ss = 0.f;
#pragma unroll
                for (int bj = 0; bj < 2; ++bj) { const int c0 = u.pn * 256 + 64 * wc + 32 * bj + 8 * fq; float* xp = X + (size_t)r * 1024 + c0;
                    const f32x4 a = *(const f32x4*)xp + acc[ai][bj][m][0], b = *(const f32x4*)(xp + 4) + acc[ai][bj][m][1];
                    *(f32x4*)xp = a; *(f32x4*)(xp + 4) = b; ss += sq4(a) + sq4(b);
                    if (XB) st_bf16x8(XB + (size_t)r * 1024 + c0, a, b); }
                if (ssq_next) { ss = fq_sum(ss); if (fq == 0) atomicAdd(ssq_next + r, ss); }
            }
    }
};

struct EpiFfnIn {
    const float* ssq; bf16_t* ACT;
    __device__ __forceinline__ void operator()(const Acc& acc, const Unit& u, int wr, int wc, int fr, int fq) const {
#pragma unroll
        for (int ai = 0; ai < 2; ++ai)
#pragma unroll
            for (int m = 0; m < 4; ++m) { const int r = EPI_ROWS(ai, m); const float inv = rsqrtf(ssq[r] * (1.f / 1024.f) + EPSF);
                f32x4 o[2];
#pragma unroll
                for (int n = 0; n < 2; ++n) { const f32x4 g = acc[ai][0][m][n] * inv, up = acc[ai][1][m][n] * inv;
#pragma unroll
                    for (int j = 0; j < 4; ++j) { const float e = __builtin_amdgcn_exp2f(-1.4426950408889634f * g[j]); o[n][j] = g[j] * __builtin_amdgcn_rcpf(1.f + e) * up[j]; } }
                st_bf16x8(ACT + (size_t)r * 2816 + u.pn * 128 + 32 * wc + 8 * fq, o[0], o[1]);
            }
    }
};

struct EpiInB {
    const float* ssq; bf16_t* CQ; float* ssqcq; bf16_t* QM; const float* gq; float* CK; int j;
    __device__ __forceinline__ void operator()(const Acc& acc, const Unit& u, int wr, int wc, int fr, int fq) const {
        const int grp = u.pn * 4 + wc;
#pragma unroll
        for (int ai = 0; ai < 2; ++ai)
#pragma unroll
            for (int m = 0; m < 4; ++m) { const int r = EPI_ROWS(ai, m); const float inv = rsqrtf(ssq[r] * (1.f / 1024.f) + EPSF);
                if (grp < 6) { float ss = 0.f;
#pragma unroll
                    for (int bj = 0; bj < 2; ++bj) { const int c0 = grp * 64 + 32 * bj + 8 * fq; const f32x4 a = acc[ai][bj][m][0] * inv, b = acc[ai][bj][m][1] * inv; ss += sq4(a) + sq4(b);
                        st_bf16x8(CQ + (size_t)r * 384 + c0, a, b); }
                    ss = fq_sum(ss); if (fq == 0) atomicAdd(ssqcq + r, ss);
                } else if (grp < 10) qm_head_store(acc, ai, m, inv, gq, QM + (size_t)r * 256 + (grp - 6) * 64, fq);
                else if (grp == 10) { if (j == 0) { *(f32x4*)(CK + (size_t)r * 288 + 256 + 8 * fq) = acc[ai][0][m][0] * inv; *(f32x4*)(CK + (size_t)r * 288 + 256 + 8 * fq + 4) = acc[ai][0][m][1] * inv; } }
                else if (grp >= 12) {
#pragma unroll
                    for (int bj = 0; bj < 2; ++bj) { const int c0 = (grp - 12) * 64 + 32 * bj + 8 * fq; *(f32x4*)(CK + (size_t)r * 288 + c0) = acc[ai][bj][m][0] * inv; *(f32x4*)(CK + (size_t)r * 288 + c0 + 4) = acc[ai][bj][m][1] * inv; } }
            }
    }
};

struct EpiUq {
    const float* ssqcq; float* ssqq; bf16_t* QF; const float* gq  ; const float* gkn  ; const float* gkr  ; const float* ropec; const float* ropes;
    __device__ __forceinline__ void operator()(const Acc& acc, const Unit& u, int wr, int wc, int fr, int fq) const {
        if (u.pn == 4 && wc >= 2) return;
#pragma unroll
        for (int ai = 0; ai < 2; ++ai)
#pragma unroll
            for (int m = 0; m < 4; ++m) { const int r = EPI_ROWS(ai, m); const float inv = rsqrtf(ssqcq[r] * (1.f / 384.f) + EPSF);
                if (u.pn < 3) { const int h = u.pn * 4 + wc; float ss = 0.f;
#pragma unroll
                    for (int bj = 0; bj < 2; ++bj) { const int d0 = 32 * bj + 8 * fq; const f32x4 a = acc[ai][bj][m][0] * inv, b = acc[ai][bj][m][1] * inv; ss += sq4(a) + sq4(b);
                        const f32x4 g0 = *(const f32x4*)(gq + d0) * *(const f32x4*)(gkn + d0), g1 = *(const f32x4*)(gq + d0 + 4) * *(const f32x4*)(gkn + d0 + 4);
                        st_bf16x8(QF + ((size_t)r * 12 + h) * 96 + d0, a * g0, b * g1); }
                    ss = fq_sum(ss); if (fq == 0) atomicAdd(ssqq + (size_t)r * 12 + h, ss);
                } else { const int ri = rope_idx(r); const int i0 = 8 * fq;
#pragma unroll
                    for (int bj = 0; bj < 2; ++bj) { const int h = (u.pn - 3) * 8 + 2 * wc + bj; f32x4 o[2]; float ss = 0.f;
#pragma unroll
                        for (int n = 0; n < 2; ++n) { const f32x4 v = acc[ai][bj][m][n] * inv; ss += sq4(v);
                            const f32x4 x = v * *(const f32x4*)(gq + 64 + i0 + 4 * n);
                            f32x4 pr; pr[0] = __shfl_xor(x[0], 32); pr[1] = __shfl_xor(x[1], 32); pr[2] = __shfl_xor(x[2], 32); pr[3] = __shfl_xor(x[3], 32);
                            const int f0 = (i0 & 15) + 4 * n; const f32x4 cs = *(const f32x4*)(ropec + ri * 16 + f0), sn = *(const f32x4*)(ropes + ri * 16 + f0), gk = *(const f32x4*)(gkr + f0);
                            o[n] = ((fq < 2) ? (x * cs - pr * sn) : (pr * sn + x * cs)) * gk; }
                        ss = fq_sum(ss); if (fq == 0) atomicAdd(ssqq + (size_t)r * 12 + h, ss);
                        st_bf16x8(QF + ((size_t)r * 12 + h) * 96 + 64 + i0, o[0], o[1]); }
                }
                asm volatile("" ::: "memory");
            }
    }
};

struct EpiKvUp {
    const bf16_t* KVB; bf16_t* KF; bf16_t* VF; float* KINV; int kf_rows;
    __device__ __forceinline__ void operator()(const Acc& acc, const Unit& u, int wr, int wc, int fr, int fq) const {
#pragma unroll
        for (int ai = 0; ai < 2; ++ai)
#pragma unroll
            for (int m = 0; m < 4; ++m) { const size_t r = (size_t)u.pm * BM + ai * HALF + wr * 64 + m * 16 + fr;
                if (u.pn < 3) { const int h = u.pn * 4 + wc; float ss = 0.f;
#pragma unroll
                    for (int bj = 0; bj < 2; ++bj) ss += sq4(acc[ai][bj][m][0]) + sq4(acc[ai][bj][m][1]);
                    const u32x4 kw = *(const u32x4*)(KVB + r * 288 + 256 + 8 * fq);
                    const float k0 = bflo(kw.x), k1 = bfhi(kw.x), k2 = bflo(kw.y), k3 = bfhi(kw.y), k4 = bflo(kw.z), k5 = bfhi(kw.z), k6 = bflo(kw.w), k7 = bfhi(kw.w);
                    ss += (k0 * k0 + k1 * k1) + (k2 * k2 + k3 * k3) + (k4 * k4 + k5 * k5) + (k6 * k6 + k7 * k7);
                    ss = fq_sum(ss);
                    const float kinv = rsqrtf(ss * (1.f / 96.f) + EPSF);
                    if (fq == 0) KINV[r * 12 + h] = kinv;
                    if (r < (size_t)kf_rows) { bf16_t* kp = KF + (r * 12 + h) * 96;
#pragma unroll
                        for (int bj = 0; bj < 2; ++bj) st_bf16x8(kp + 32 * bj + 8 * fq, acc[ai][bj][m][0] * kinv, acc[ai][bj][m][1] * kinv);
                        st_bf16x8(kp + 64 + 8 * fq, (f32x4){k0, k1, k2, k3} * kinv, (f32x4){k4, k5, k6, k7} * kinv); }
                } else if (VF && r < (size_t)kf_rows) { const int h = (u.pn - 3) * 4 + wc;
#pragma unroll
                    for (int bj = 0; bj < 2; ++bj) st_bf16x8(VF + (r * 12 + h) * 64 + 32 * bj + 8 * fq, acc[ai][bj][m][0], acc[ai][bj][m][1]); }
                asm volatile("" ::: "memory");
            }
    }
};

struct EpiMemKv {
    float* mem_k; float* mem_v; bf16_t* MKB; bf16_t* MVB; const float* gk;
    __device__ __forceinline__ void operator()(const Acc& acc, const Unit& u, int wr, int wc, int fr, int fq) const {
        const int l = u.pn >> 1;
#pragma unroll
        for (int ai = 0; ai < 2; ++ai)
#pragma unroll
            for (int m = 0; m < 4; ++m) { const int r = EPI_ROWS(ai, m); const size_t o = ((size_t)l * 2048 + r) * 256 + wc * 64;
                if (!(u.pn & 1)) { float ss = 0.f;
#pragma unroll
                    for (int bj = 0; bj < 2; ++bj) ss += sq4(acc[ai][bj][m][0]) + sq4(acc[ai][bj][m][1]);
                    ss = fq_sum(ss); const float sc = rsqrtf(ss * (1.f / 64.f) + EPSF);
#pragma unroll
                    for (int bj = 0; bj < 2; ++bj) { const int d0 = 32 * bj + 8 * fq; const f32x4 a = acc[ai][bj][m][0] * sc * *(const f32x4*)(gk + l * 64 + d0), b = acc[ai][bj][m][1] * sc * *(const f32x4*)(gk + l * 64 + d0 + 4);
                        *(f32x4*)(mem_k + o + d0) = a; *(f32x4*)(mem_k + o + d0 + 4) = b; st_bf16x8(MKB + o + d0, a, b); }
                } else {
#pragma unroll
                    for (int bj = 0; bj < 2; ++bj) { const int d0 = 32 * bj + 8 * fq; const f32x4 a = acc[ai][bj][m][0], b = acc[ai][bj][m][1];
                        *(f32x4*)(mem_v + o + d0) = a; *(f32x4*)(mem_v + o + d0 + 4) = b; st_bf16x8(MVB + o + d0, a, b); }
                }
            }
    }
};
}
namespace fk {
__device__ __forceinline__ float inv_freq_of(int i) {
    switch (i) { case 0: return 1.000000000e+00f; case 1: return 5.623413324e-01f; case 2: return 3.162277639e-01f; case 3: return 1.778279394e-01f;
        case 4: return 1.000000015e-01f; case 5: return 5.623413250e-02f; case 6: return 3.162277490e-02f; case 7: return 1.778279431e-02f;
        case 8: return 9.999999776e-03f; case 9: return 5.623413250e-03f; case 10: return 3.162277630e-03f; case 11: return 1.778279431e-03f;
        case 12: return 1.000000047e-03f; case 13: return 5.623413017e-04f; case 14: return 3.162277571e-04f; default: return 1.778279402e-04f; }
}

struct WDesc { const float* W; int ldw, s0, c0, ncols, nvalid, K; const float* kgain; bf16_t* Bt; int mode; };
constexpr int WT_NG = 28;
__device__ __forceinline__ void wt_desc(const P& p, int g, WDesc& d) {
    d.s0 = 0; d.c0 = 0; d.kgain = nullptr; d.mode = 0;
    if (g < 2) { const int l = g; d.W = p.w_in_a + (size_t)l * 1024 * 1024; d.ldw = 1024; d.ncols = d.nvalid = 1024; d.K = 1024; d.kgain = p.norm_mix + l * 1024; d.Bt = p.BT_A1 + (size_t)l * 1024 * 1024; }
    else if (g < 6) { const int l = g - 2; d.W = p.w_out + (size_t)l * 1024 * 1024; d.ldw = 1024; d.ncols = d.nvalid = 1024; d.K = 1024; d.Bt = p.BT_OUT + (size_t)l * 1024 * 1024; }
    else if (g < 10) { const int l = g - 6; d.W = p.w_ffn_in + (size_t)l * 1024 * 5632; d.ldw = 5632; d.ncols = d.nvalid = 5632; d.K = 1024; d.kgain = p.norm_ffn + l * 1024; d.Bt = p.BT_F1 + (size_t)l * 5632 * 1024; d.mode = 1; }
    else if (g < 14) { const int l = g - 10; d.W = p.w_ffn_out + (size_t)l * 2816 * 1024; d.ldw = 1024; d.ncols = d.nvalid = 1024; d.K = 2816; d.Bt = p.BT_F2 + (size_t)l * 1024 * 2816; }
    else if (g == 14) { d.W = p.w_in_b; d.ldw = 640; d.ncols = d.nvalid = 640; d.K = 1024; d.kgain = p.norm_mix + 2 * 1024; d.Bt = p.BT_B1; }
    else if (g == 15) { d.W = p.w_dkv; d.ldw = 288; d.s0 = 256; d.c0 = 640; d.ncols = 64; d.nvalid = 32; d.K = 1024; d.kgain = p.norm_kv; d.Bt = p.BT_B1; }
    else if (g == 16) { d.W = nullptr; d.ldw = 0; d.c0 = 704; d.ncols = 64; d.nvalid = 0; d.K = 1024; d.Bt = p.BT_B1; }
    else if (g == 17) { d.W = p.w_dkv; d.ldw = 288; d.c0 = 768; d.ncols = d.nvalid = 256; d.K = 1024; d.kgain = p.norm_kv; d.Bt = p.BT_B1; }
    else if (g == 18) { d.W = p.w_in_b + (size_t)1024 * 640; d.ldw = 640; d.ncols = d.nvalid = 640; d.K = 1024; d.kgain = p.norm_mix + 3 * 1024; d.Bt = p.BT_B1 + (size_t)1024 * 1024; }
    else if (g == 19) { d.W = nullptr; d.ldw = 0; d.c0 = 640; d.ncols = 128; d.nvalid = 0; d.K = 1024; d.Bt = p.BT_B1 + (size_t)1024 * 1024; }
    else if (g < 22) { const int j = g - 20; d.W = p.w_uq + (size_t)j * 384 * 1152; d.ldw = 1152; d.ncols = 1280; d.nvalid = 1280; d.K = 384; d.kgain = p.g_q_lora + j * 384; d.Bt = p.BT_UQ + (size_t)j * 1280 * 384; d.mode = 2; }
    else if (g == 22) { d.W = p.w_uk; d.ldw = 768; d.ncols = d.nvalid = 768; d.K = 256; d.Bt = p.BT_KV; }
    else if (g == 23) { d.W = p.w_uv; d.ldw = 768; d.c0 = 768; d.ncols = d.nvalid = 768; d.K = 256; d.Bt = p.BT_KV; }
    else { const int l = g - 24; d.W = p.w_mem_kv + (size_t)l * 1024 * 512; d.ldw = 512; d.c0 = l * 512; d.ncols = d.nvalid = 512; d.K = 1024; d.kgain = p.norm_mem + l * 1024; d.Bt = p.BT_MEM; }
}
__device__ __forceinline__ int wt_items(const WDesc& d) { return (d.ncols >> 6) * (d.K >> 6); }
__device__ __forceinline__ int wt_src(const WDesc& d, int c) {
    if (d.mode == 0) { const int q = c - d.c0; return (q < d.nvalid) ? d.s0 + q : -1; }
    if (d.mode == 1) { const int pn = c >> 8, L = c & 255, wc = L >> 6, bj = (L >> 5) & 1, i = L & 31; return bj * 2816 + 128 * pn + 32 * wc + i; }
    if (c < 768) return (c >> 6) * 96 + (c & 63);
    if (c < 1152) return ((c - 768) >> 5) * 96 + 64 + ((c - 768) & 31);
    return -1;
}
__device__ __forceinline__ void wt_item(const WDesc& d, int item, LAS float* scr) {
    const int nkb = d.K >> 6, cb = item / nkb, kb = item % nkb, t = opaque_tid();
    { const int cl = t & 63, ks = t >> 6, c = d.c0 + cb * 64 + cl; const int sc = d.W ? wt_src(d, c) : -1;
#pragma unroll
      for (int i = 0; i < 8; ++i) { const int k = kb * 64 + ks + 8 * i; scr[(ks + 8 * i) * 65 + cl] = (sc >= 0) ? d.W[(size_t)k * d.ldw + sc] : 0.f; } }
    __syncthreads();
    { const int cl = t >> 3, kc = t & 7, c = d.c0 + cb * 64 + cl, k0 = kb * 64 + 8 * kc; float v[8];
#pragma unroll
      for (int i = 0; i < 8; ++i) v[i] = scr[(8 * kc + i) * 65 + cl] * (d.kgain ? d.kgain[k0 + i] : 1.f);
      const size_t row = (size_t)(c >> 8) * 256 + slot_of_logical(c & 255);
      u32x4 w; w.x = pk2(v[0], v[1]); w.y = pk2(v[2], v[3]); w.z = pk2(v[4], v[5]); w.w = pk2(v[6], v[7]);
      *(u32x4*)(d.Bt + row * d.K + k0) = w; }
    __syncthreads();
}

__device__ __forceinline__ void p0_prologue(const P& p, LAS float* scr, int bid, int nb) {
    const int tid = opaque_tid(), lane = tid & 63, wid = tid >> 6;
    const long gt = (long)bid * NTHR + tid, gn = (long)nb * NTHR;
    for (int r = bid * 8 + wid; r < MT; r += nb * 8) {
        const float* src = (r < MP) ? p.x_prompt + (size_t)r * 1024 : p.x_sample + (size_t)(r - MP) * 1024; float ss = 0.f;
#pragma unroll
        for (int i = 0; i < 2; ++i) { const int c = i * 512 + lane * 8; const f32x4 a = *(const f32x4*)(src + c), b = *(const f32x4*)(src + c + 4);
            *(f32x4*)(p.X + (size_t)r * 1024 + c) = a; *(f32x4*)(p.X + (size_t)r * 1024 + c + 4) = b; st_bf16x8(p.XB + (size_t)r * 1024 + c, a, b); ss += sq4(a) + sq4(b); }
        ss = wsum(ss); if (lane == 0) p.SSQ[r] = ss;
    }
    for (int r = bid * 8 + wid; r < 2048; r += nb * 8) {
        const float* src = p.mem_prompt + (size_t)r * 1024; f32x4 a[2], b[2]; float ss = 0.f;
#pragma unroll
        for (int i = 0; i < 2; ++i) { const int c = i * 512 + lane * 8; a[i] = *(const f32x4*)(src + c); b[i] = *(const f32x4*)(src + c + 4); ss += sq4(a[i]) + sq4(b[i]); }
        ss = wsum(ss); const float sc = rsqrtf(ss * (1.f / 1024.f) + EPSF);
#pragma unroll
        for (int i = 0; i < 2; ++i) st_bf16x8(p.HM + (size_t)r * 1024 + i * 512 + lane * 8, a[i] * sc, b[i] * sc);
    }
    for (long i = gt; i < 2056 * 16; i += gn) { const int idx = (int)(i >> 4), f = (int)(i & 15); const float pos = (float)(idx < 2048 ? idx : 16384 + idx - 2048);
        const float ang = pos * inv_freq_of(f); p.ROPEC[i] = cosf(ang); p.ROPES[i] = sinf(ang); }
    for (long i = gt; i < (long)4 * 32 * 65536 / 8; i += gn) {
        { const f32x4 a = *(const f32x4*)(p.cache_mem_k + i * 8), b = *(const f32x4*)(p.cache_mem_k + i * 8 + 4); st_bf16x8(p.MKS + i * 8, a, b); }
        { const f32x4 a = *(const f32x4*)(p.cache_mem_v + i * 8), b = *(const f32x4*)(p.cache_mem_v + i * 8 + 4); st_bf16x8(p.MVS + i * 8, a, b); } }
    for (long i = gt; i < (long)2 * 768 * 48; i += gn) { const int l = (int)(i / (768 * 48)), rem = (int)(i % (768 * 48)), c = rem / 48, kc = rem % 48;
        const int pn = c >> 8, g = c / 192, e = c % 192; float v[8];
#pragma unroll
        for (int q = 0; q < 8; ++q) { const int cin = 192 * pn + 8 * kc + q - 192 * g; v[q] = (cin >= 0 && cin < 192) ? p.w_pool_grp[(((size_t)l * 4 + g) * 192 + cin) * 192 + e] * p.pool_scale[l * 768 + c] : 0.f; }
        u32x4 w; w.x = pk2(v[0], v[1]); w.y = pk2(v[2], v[3]); w.z = pk2(v[4], v[5]); w.w = pk2(v[6], v[7]);
        *(u32x4*)(p.BT_MIX + ((size_t)l * 768 + (size_t)pn * 256 + slot_of_logical(c & 255)) * 384 + 8 * kc) = w; }
    for (long i = gt; i < 256 * 768 / 8; i += gn) { const f32x4 a = *(const f32x4*)(p.w_uk + i * 8), b = *(const f32x4*)(p.w_uk + i * 8 + 4); st_bf16x8(p.WUKB + i * 8, a, b); }
    { int base = 0;
      for (int g = 0; g < WT_NG; ++g) { WDesc d; wt_desc(p, g, d); const int n = wt_items(d);
          int first = (bid - base % nb + nb) % nb;
          for (int it = first; it < n; it += nb) wt_item(d, it, scr);
          base += n; } }
}
__device__ __forceinline__ void p0_gather_cache(const P& p, int bid, int nb) {
    const long gt = (long)bid * NTHR + opaque_tid(), gn = (long)nb * NTHR;
    for (long i = gt; i < (long)32 * 16384 * 36; i += gn) { const long row = i / 36; const int ch = (int)(i % 36); const int b = (int)(row >> 14), k = (int)(row & 16383);
        const int page = p.page_table[b * 128 + (k >> 7)]; const float* src = p.cache_kv + ((size_t)page * 128 + (k & 127)) * 288 + ch * 8;
        st_bf16x8(p.KVBS + row * 288 + ch * 8, *(const f32x4*)src, *(const f32x4*)(src + 4)); }
}

__device__ __forceinline__ void t_poolprep(const P& p, int l, int bid, int nb) {
    const long gt = (long)bid * NTHR + opaque_tid(), gn = (long)nb * NTHR;
    const float* prev = p.state_pool + (size_t)l * 32 * 15 * 768;
    for (long i = gt; i < (long)MT * 96; i += gn) { const int r = (int)(i / 96), ch = (int)(i % 96), c = ch * 8, g = c / 192, w = 2 << g;
        float sum[8], cur[8];
#pragma unroll
        for (int q = 0; q < 8; ++q) sum[q] = 0.f;
        const int t = (r < MP) ? (r & 2047) : ((r - MP) & 7); const int b = (r - MP) >> 3;
        for (int j = 0; j < w; ++j) { const int tt = t - j;
            if (tt >= 0) { const u32x4 v = *(const u32x4*)(p.U + (size_t)(r - j) * 768 + c);
                const float f[8] = {bflo(v.x), bfhi(v.x), bflo(v.y), bfhi(v.y), bflo(v.z), bfhi(v.z), bflo(v.w), bfhi(v.w)};
#pragma unroll
                for (int q = 0; q < 8; ++q) { sum[q] += f[q]; if (j == 0) cur[q] = f[q]; } }
            else if (r >= MP) { const float* s = prev + ((size_t)b * 15 + 15 + tt) * 768 + c;
#pragma unroll
                for (int q = 0; q < 8; ++q) sum[q] += s[q]; } }
        const float inv = (r < MP) ? 1.f / (float)((t + 1 < w) ? (t + 1) : w) : 1.f / (float)w;
        u32x4 o; o.x = pk2(sum[0] * inv - cur[0], sum[1] * inv - cur[1]); o.y = pk2(sum[2] * inv - cur[2], sum[3] * inv - cur[3]);
        o.z = pk2(sum[4] * inv - cur[4], sum[5] * inv - cur[5]); o.w = pk2(sum[6] * inv - cur[6], sum[7] * inv - cur[7]);
        *(u32x4*)(p.DIFF + (size_t)r * 768 + c) = o; }
    float* ps = p.pool_s + (size_t)l * 32 * 15 * 768;
    for (long i = gt; i < (long)32 * 7 * 768; i += gn) { const int b = (int)(i / (7 * 768)), rem = (int)(i % (7 * 768)), t = rem / 768, c = rem % 768;
        ps[((size_t)b * 15 + t) * 768 + c] = prev[((size_t)b * 15 + t + 8) * 768 + c]; }
}

__device__ __forceinline__ void t_kvrows(const P& p, int bid, int nb) {
    const int tid = opaque_tid(), lane = tid & 63, wid = tid >> 6;
    for (int r = bid * 8 + wid; r < MT; r += nb * 8) {
        const float* s = p.CK + (size_t)r * 288; const f32x4 v = *(const f32x4*)(s + lane * 4);
        const float ss = wsum(sq4(v)); const float sc = rsqrtf(ss * (1.f / 256.f) + EPSF);
        const f32x4 o = v * sc * *(const f32x4*)(p.g_kv_lora + lane * 4);
        *(f32x4*)(p.KVO + (size_t)r * 288 + lane * 4) = o; u32x2 w; w.x = pk2(o[0], o[1]); w.y = pk2(o[2], o[3]); *(u32x2*)(p.KVB + (size_t)r * 288 + lane * 4) = w;
        if (lane < 16) { const int ri = rope_idx(r); const float cs = p.ROPEC[ri * 16 + lane], sn = p.ROPES[ri * 16 + lane]; const float x1 = s[256 + lane], x2 = s[272 + lane];
            const float o1 = x1 * cs - x2 * sn, o2 = x1 * sn + x2 * cs; p.KVO[(size_t)r * 288 + 256 + lane] = o1; p.KVO[(size_t)r * 288 + 272 + lane] = o2;
            p.KVB[(size_t)r * 288 + 256 + lane] = (bf16_t)f2bf(o1); p.KVB[(size_t)r * 288 + 272 + lane] = (bf16_t)f2bf(o2); }
    }
}
}
namespace fk {
typedef short v4i16_t __attribute__((ext_vector_type(4)));
#define MFMA32(a, b, c) __builtin_amdgcn_mfma_f32_32x32x16_bf16((a), (b), (c), 0, 0, 0)
__device__ __forceinline__ s16x4 tr_read4(const LAS unsigned char* p) { return __builtin_bit_cast(s16x4, __builtin_amdgcn_ds_read_tr16_b64_v4i16((LAS v4i16_t*)p)); }
__device__ __forceinline__ int crow(int reg, int hi) { return (reg & 3) + 8 * (reg >> 2) + 4 * hi; }
__device__ __forceinline__ bf16x8 pack8(const f32x16& x, int s) {
    u32x4 w; w.x = pk2(x[8 * s], x[8 * s + 1]); w.y = pk2(x[8 * s + 2], x[8 * s + 3]); w.z = pk2(x[8 * s + 4], x[8 * s + 5]); w.w = pk2(x[8 * s + 6], x[8 * s + 7]);
    return __builtin_bit_cast(bf16x8, w);
}

template <int DQK, bool CAUSAL>
__device__ __forceinline__ void attn_unit(LAS unsigned char* lds, const bf16_t* Q, int q_stride, const float* qss, int qss_stride, float qconst,
                                          const bf16_t* K, int k_stride, const bf16_t* V, int v_stride, int ntiles, bf16_t* O, int o_stride, int q0, int nq_valid) {
    constexpr int RSK = DQK * 2 + 16, RSV = 192, NS = DQK / 16, KCH = DQK / 8, KBUF = 64 * RSK, VBUF = 64 * RSV;
    const int tid = opaque_tid(), wid = tid >> 6, lane = tid & 63, l31 = lane & 31, hi = lane >> 5;
    const bool wave_on = (32 * wid < nq_valid);
    int qrow = 32 * wid + l31; const bool q_ok = qrow < nq_valid; if (!q_ok) qrow = nq_valid - 1;
    bf16x8 qf[NS];
    { float sc = 1.f; if (qss) sc = rsqrtf(qss[(size_t)qrow * qss_stride] * (1.f / 96.f) + EPSF) * qconst;
#pragma unroll
      for (int s = 0; s < NS; ++s) { const u32x4 w = *(const u32x4*)(Q + (size_t)qrow * q_stride + 16 * s + 8 * hi);
          if (qss) { u32x4 o; o.x = pk2(bflo(w.x) * sc, bfhi(w.x) * sc); o.y = pk2(bflo(w.y) * sc, bfhi(w.y) * sc); o.z = pk2(bflo(w.z) * sc, bfhi(w.z) * sc); o.w = pk2(bflo(w.w) * sc, bfhi(w.w) * sc); qf[s] = __builtin_bit_cast(bf16x8, o); }
          else qf[s] = __builtin_bit_cast(bf16x8, w); } }
    f32x16 ot[2];
#pragma unroll
    for (int i = 0; i < 16; ++i) { ot[0][i] = 0.f; ot[1][i] = 0.f; }
    float mrun = -1e30f, lsum = 0.f;
    const int qw_last = q0 + 32 * wid + 31;
    u32x4 kst[2], vst;
    const int vkey = tid >> 3, vch = tid & 7;
    auto load_tile = [&](int t) {
#pragma unroll
        for (int i = 0; i < 2; ++i) { const int c = tid + i * NTHR; if (c < 64 * KCH) { const int key = c / KCH, ch = c % KCH; kst[i] = *(const u32x4*)(K + (size_t)(64 * t + key) * k_stride + ch * 8); } }
        vst = *(const u32x4*)(V + (size_t)(64 * t + vkey) * v_stride + vch * 8);
    };
    auto store_tile = [&](int buf) {
#pragma unroll
        for (int i = 0; i < 2; ++i) { const int c = tid + i * NTHR; if (c < 64 * KCH) { const int key = c / KCH, ch = c % KCH; *(LAS u32x4*)(lds + buf * KBUF + key * RSK + ch * 16) = kst[i]; } }
        *(LAS u32x4*)(lds + 2 * KBUF + buf * VBUF + vkey * RSV + vch * 16) = vst;
    };
    __syncthreads();
    load_tile(0); store_tile(0);
    __syncthreads();
    for (int t = 0; t < ntiles; ++t) {
        if (t + 1 < ntiles) load_tile(t + 1);
        const bool tile_on = wave_on && (!CAUSAL || 64 * t <= qw_last);
        if (tile_on) {
            const LAS unsigned char* kb = lds + (t & 1) * KBUF; const LAS unsigned char* vb = lds + 2 * KBUF + (t & 1) * VBUF;
            f32x16 st[2];
#pragma unroll
            for (int b = 0; b < 2; ++b) {
#pragma unroll
                for (int i = 0; i < 16; ++i) st[b][i] = 0.f;
#pragma unroll
                for (int s = 0; s < NS; ++s) { const bf16x8 kf = *(const LAS bf16x8*)(kb + (32 * b + l31) * RSK + (16 * s + 8 * hi) * 2); st[b] = MFMA32(kf, qf[s], st[b]); }
            }
            if (CAUSAL && 64 * t + 63 > q0 + 32 * wid) {
                const int qpos = q0 + 32 * wid + l31;
#pragma unroll
                for (int b = 0; b < 2; ++b)
#pragma unroll
                    for (int i = 0; i < 16; ++i) if (64 * t + 32 * b + crow(i, hi) > qpos) st[b][i] = -1e30f;
            }
            float mx = st[0][0];
#pragma unroll
            for (int b = 0; b < 2; ++b)
#pragma unroll
                for (int i = 0; i < 16; ++i) mx = fmaxf(mx, st[b][i]);
            mx = fmaxf(mx, __shfl_xor(mx, 32));
            const float mnew = fmaxf(mrun, mx), alpha = __builtin_amdgcn_exp2f(mrun - mnew); mrun = mnew;
            float ps = 0.f;
#pragma unroll
            for (int b = 0; b < 2; ++b)
#pragma unroll
                for (int i = 0; i < 16; ++i) { const float e = __builtin_amdgcn_exp2f(st[b][i] - mnew); st[b][i] = e; ps += e; }
            lsum = lsum * alpha + ps;
#pragma unroll
            for (int i = 0; i < 16; ++i) { ot[0][i] *= alpha; ot[1][i] *= alpha; }
#pragma unroll
            for (int b = 0; b < 2; ++b)
#pragma unroll
                for (int s2 = 0; s2 < 2; ++s2) { const bf16x8 pf = pack8(st[b], s2);
                    const int rb = 32 * b + 16 * s2 + 4 * hi + ((lane & 15) >> 2);
#pragma unroll
                    for (int db = 0; db < 2; ++db) { const LAS unsigned char* a = vb + rb * RSV + 64 * db + 32 * ((lane >> 4) & 1) + 8 * (lane & 3);
                        const s16x4 lo = tr_read4(a), hh = tr_read4(a + 8 * RSV);
                        const bf16x8 vf = __builtin_shufflevector(lo, hh, 0, 1, 2, 3, 4, 5, 6, 7);
                        ot[db] = MFMA32(vf, pf, ot[db]); } }
        }
        if (t + 1 < ntiles) store_tile((t + 1) & 1);
        __syncthreads();
    }
    if (wave_on) { const float ltot = lsum + __shfl_xor(lsum, 32); const float inv = 1.f / ltot;
        if (q_ok) {
#pragma unroll
            for (int db = 0; db < 2; ++db)
#pragma unroll
                for (int g = 0; g < 4; ++g) { u32x2 w; w.x = pk2(ot[db][4 * g] * inv, ot[db][4 * g + 1] * inv); w.y = pk2(ot[db][4 * g + 2] * inv, ot[db][4 * g + 3] * inv);
                    *(u32x2*)(O + (size_t)qrow * o_stride + 32 * db + 8 * g + 4 * hi) = w; } } }
}

constexpr float LOG2E = 1.4426950408889634f;
constexpr float MLA_QCONST = 0.10206207261596577f * LOG2E;

__device__ __forceinline__ void memattn_phase(const P& p, LAS unsigned char* lds, int l, int bid, int nb) {
    for (int u = bid; u < 256 + 128; u += nb) {
        if (u < 256) { const int b = u >> 5, h = (u >> 3) & 3, qb = u & 7; const size_t r0 = (size_t)b * 2048 + 256 * qb;
            attn_unit<64, false>(lds, p.QM + r0 * 256 + h * 64, 256, nullptr, 0, 1.f, p.MKB + ((size_t)l * 2048 + b * 256) * 256 + h * 64, 256, p.MVB + ((size_t)l * 2048 + b * 256) * 256 + h * 64, 256, 4,
                                 p.CAT + r0 * 1024 + 768 + h * 64, 1024, 0, 256); }
        else { const int v = u - 256, b = v >> 2, h = v & 3; const size_t r0 = (size_t)MP + b * 8;
            attn_unit<64, false>(lds, p.QM + r0 * 256 + h * 64, 256, nullptr, 0, 1.f, p.MKS + ((size_t)l * 32 + b) * 65536 + h * 64, 256, p.MVS + ((size_t)l * 32 + b) * 65536 + h * 64, 256, 4,
                                 p.CAT + r0 * 1024 + 768 + h * 64, 1024, 0, 8); }
    }
}

__device__ __forceinline__ void mla_prompt_phase(const P& p, LAS unsigned char* lds, int j, int bid, int nb) {
    for (int u = bid; u < 768; u += nb) { const int qb = 7 - (u / 96), bh = u % 96, b = bh / 12, h = bh % 12; const size_t r0 = (size_t)b * 2048 + 256 * qb;
        attn_unit<96, true>(lds, p.QF + (r0 * 12 + h) * 96, 1152, p.SSQQ + ((size_t)j * MT + r0) * 12 + h, 12, MLA_QCONST,
                            p.KF + ((size_t)b * 2048 * 12 + h) * 96, 1152, p.VF + ((size_t)b * 2048 * 12 + h) * 64, 768, 4 * (qb + 1), p.CAT + r0 * 1024 + h * 64, 1024, 256 * qb, 256); }
}
}

namespace fk {
constexpr int SA_RS = 592;
constexpr int SA_QBUF = 96 * SA_RS, SA_KBUF = 64 * SA_RS, SA_KIBUF = 64 * 12 * 4;
constexpr int SA_LDS = SA_QBUF + 2 * SA_KBUF + 2 * SA_KIBUF;
__device__ __forceinline__ void mla_sample_unit(const P& p, LAS unsigned char* lds, int j, int b, int sp) {
    const int tid = opaque_tid(), wid = tid >> 6, lane = tid & 63, l31 = lane & 31, hi = lane >> 5;
    LAS unsigned char* qbuf = lds; LAS unsigned char* kbuf = lds + SA_QBUF; LAS unsigned char* kibuf = lds + SA_QBUF + 2 * SA_KBUF;
    const size_t row0 = (size_t)MP + b * 8;
    __syncthreads();
    { const int c = tid & 255;
#pragma unroll 1
      for (int h = tid >> 8; h < 12; h += 2) {
          float wv[64];
#pragma unroll
          for (int i = 0; i < 8; ++i) { const u32x4 w = *(const u32x4*)(p.WUKB + (size_t)c * 768 + h * 64 + i * 8);
              wv[8 * i] = bflo(w.x); wv[8 * i + 1] = bfhi(w.x); wv[8 * i + 2] = bflo(w.y); wv[8 * i + 3] = bfhi(w.y); wv[8 * i + 4] = bflo(w.z); wv[8 * i + 5] = bfhi(w.z); wv[8 * i + 6] = bflo(w.w); wv[8 * i + 7] = bfhi(w.w); }
#pragma unroll 1
          for (int t = 0; t < 8; ++t) { const bf16_t* qp = p.QF + ((row0 + t) * 12 + h) * 96; float acc = 0.f;
#pragma unroll
              for (int i = 0; i < 8; ++i) { const u32x4 w = *(const u32x4*)(qp + i * 8);
                  acc += bflo(w.x) * wv[8 * i] + bfhi(w.x) * wv[8 * i + 1] + bflo(w.y) * wv[8 * i + 2] + bfhi(w.y) * wv[8 * i + 3] + bflo(w.z) * wv[8 * i + 4] + bfhi(w.z) * wv[8 * i + 5] + bflo(w.w) * wv[8 * i + 6] + bfhi(w.w) * wv[8 * i + 7]; }
              const float sc = rsqrtf(p.SSQQ[((size_t)j * MT + row0 + t) * 12 + h] * (1.f / 96.f) + EPSF) * MLA_QCONST;
              *(LAS bf16_t*)(qbuf + (t * 12 + h) * SA_RS + c * 2) = (bf16_t)f2bf(acc * sc); } }
      if (tid < 96 * 4) { const int q = tid >> 2, ch = tid & 3, t = q / 12, h = q % 12; const u32x4 w = *(const u32x4*)(p.QF + ((row0 + t) * 12 + h) * 96 + 64 + ch * 8);
          const float sc = rsqrtf(p.SSQQ[((size_t)j * MT + row0 + t) * 12 + h] * (1.f / 96.f) + EPSF) * MLA_QCONST;
          u32x4 o; o.x = pk2(bflo(w.x) * sc, bfhi(w.x) * sc); o.y = pk2(bflo(w.y) * sc, bfhi(w.y) * sc); o.z = pk2(bflo(w.z) * sc, bfhi(w.z) * sc); o.w = pk2(bflo(w.w) * sc, bfhi(w.w) * sc);
          *(LAS u32x4*)(qbuf + q * SA_RS + 512 + ch * 16) = o; } }
    const int ntiles = (sp == 7) ? 33 : 32;
    const char* kbase = (const char*)(p.KVBS + ((size_t)b * 16384 + (size_t)sp * 2048) * 288); const char* kibase = (const char*)(p.KINVS + ((size_t)b * 16384 + (size_t)sp * 2048) * 12);
    unsigned soff[5];
#pragma unroll
    for (int i = 0; i < 5; ++i) { const int pc = wid + 8 * i; if (pc < 37) { const int g = pc * 64 + lane, row = g / 37, ch = g % 37; soff[i] = (unsigned)(row * 576 + (ch < 36 ? ch : 35) * 16); } else soff[i] = (unsigned)((pc - 37) * 1024 + lane * 16); }
#define SA_LOAD(t, buf) do { if ((t) < 32) { \
        _Pragma("unroll") for (int i = 0; i < 5; ++i) { const int pc = wid + 8 * i; \
            if (pc < 37) __builtin_amdgcn_global_load_lds((const unsigned*)(kbase + (size_t)(t) * (64 * 576) + soff[i]), (LAS unsigned*)(kbuf + (buf) * SA_KBUF + pc * 1024), 16, 0, 0); \
            else if (pc < 40) __builtin_amdgcn_global_load_lds((const unsigned*)(kibase + (size_t)(t) * (64 * 48) + soff[i]), (LAS unsigned*)(kibuf + (buf) * SA_KIBUF + (pc - 37) * 1024), 16, 0, 0); } \
      } else {   \
        if (tid < 288) { const int key = tid / 36, ch = tid % 36; *(LAS u32x4*)(kbuf + (buf) * SA_KBUF + key * SA_RS + ch * 16) = *(const u32x4*)(p.KVB + row0 * 288 + (size_t)tid * 8); } \
        if (tid < 24) *(LAS f32x4*)(kibuf + (buf) * SA_KIBUF + tid * 16) = *(const f32x4*)(p.KINV + row0 * 12 + tid * 4); \
      } } while (0)
    SA_LOAD(0, 0);
    asm volatile("s_waitcnt vmcnt(0)" ::: "memory");
    __syncthreads();
    const int qb = wid % 3, kh = wid / 3; const bool cw = wid < 6;
    const int qidx = 32 * qb + l31, hq = qidx % 12, tq = qidx / 12;
    f32x16 ot[8];
#pragma unroll
    for (int cb = 0; cb < 8; ++cb)
#pragma unroll
        for (int i = 0; i < 16; ++i) ot[cb][i] = 0.f;
    float mrun = -1e30f, lsum = 0.f;
    for (int t = 0; t < ntiles; ++t) {
        if (t + 1 < ntiles) SA_LOAD(t + 1, (t + 1) & 1);
        if (cw && (t < 32 || kh == 0)) {
            const LAS unsigned char* kb_ = kbuf + (t & 1) * SA_KBUF; const LAS float* ki = (const LAS float*)(kibuf + (t & 1) * SA_KIBUF);
            f32x16 st;
#pragma unroll
            for (int i = 0; i < 16; ++i) st[i] = 0.f;
#pragma unroll
            for (int s = 0; s < 18; ++s) { const bf16x8 kf = *(const LAS bf16x8*)(kb_ + (32 * kh + l31) * SA_RS + (16 * s + 8 * hi) * 2);
                const bf16x8 qf = *(const LAS bf16x8*)(qbuf + qidx * SA_RS + (16 * s + 8 * hi) * 2); st = MFMA32(kf, qf, st); }
#pragma unroll
            for (int i = 0; i < 16; ++i) { const int kk = 32 * kh + crow(i, hi); st[i] *= ki[kk * 12 + hq]; if (t == 32 && (kk >= 8 || kk > tq)) st[i] = -1e30f; }
            float mx = st[0];
#pragma unroll
            for (int i = 1; i < 16; ++i) mx = fmaxf(mx, st[i]);
            mx = fmaxf(mx, __shfl_xor(mx, 32));
            const float mnew = fmaxf(mrun, mx), alpha = __builtin_amdgcn_exp2f(mrun - mnew); mrun = mnew;
            float ps = 0.f;
#pragma unroll
            for (int i = 0; i < 16; ++i) { const float e = __builtin_amdgcn_exp2f(st[i] - mnew); st[i] = e; ps += e; }
            lsum = lsum * alpha + ps;
#pragma unroll
            for (int cb = 0; cb < 8; ++cb)
#pragma unroll
                for (int i = 0; i < 16; ++i) ot[cb][i] *= alpha;
#pragma unroll
            for (int s2 = 0; s2 < 2; ++s2) { const bf16x8 pf = pack8(st, s2);
                const int rb = 32 * kh + 16 * s2 + 4 * hi + ((lane & 15) >> 2);
#pragma unroll
                for (int cb = 0; cb < 8; ++cb) { const LAS unsigned char* a = kb_ + rb * SA_RS + 64 * cb + 32 * ((lane >> 4) & 1) + 8 * (lane & 3);
                    const s16x4 lo = tr_read4(a), hh = tr_read4(a + 8 * SA_RS);
                    const bf16x8 vf = __builtin_shufflevector(lo, hh, 0, 1, 2, 3, 4, 5, 6, 7);
                    ot[cb] = MFMA32(vf, pf, ot[cb]); } }
        }
        asm volatile("s_waitcnt vmcnt(0)" ::: "memory");
        __syncthreads();
    }
#undef SA_LOAD
    if (cw) { const float ltot = lsum + __shfl_xor(lsum, 32); const size_t slot = ((size_t)b * 16 + sp * 2 + kh) * 96 + qidx;
        float* op = p.OPART + slot * 256;
#pragma unroll
        for (int cb = 0; cb < 8; ++cb)
#pragma unroll
            for (int g = 0; g < 4; ++g) *(f32x4*)(op + 32 * cb + 8 * g + 4 * hi) = (f32x4){ot[cb][4 * g], ot[cb][4 * g + 1], ot[cb][4 * g + 2], ot[cb][4 * g + 3]};
        if (hi == 0) { p.MLPART[slot * 2] = mrun; p.MLPART[slot * 2 + 1] = ltot; } }
}
__device__ __forceinline__ void mla_sample_phase(const P& p, LAS unsigned char* lds, int j, int bid, int nb) {
    for (int u = bid; u < 256; u += nb) mla_sample_unit(p, lds, j, u >> 3, u & 7);
}
__device__ __forceinline__ void mla_sample_combine(const P& p, int bid, int nb) {
    const int tid = opaque_tid(), lane = tid & 63, wid = tid >> 6;
    for (int it = bid * 8 + wid; it < 32 * 96; it += nb * 8) { const int b = it / 96, q = it % 96, t = q / 12, h = q % 12;
        float m[16], mstar = -1e30f;
#pragma unroll
        for (int s = 0; s < 16; ++s) { m[s] = p.MLPART[(((size_t)b * 16 + s) * 96 + q) * 2]; mstar = fmaxf(mstar, m[s]); }
        f32x4 o = (f32x4){0.f, 0.f, 0.f, 0.f}; float L = 0.f;
#pragma unroll
        for (int s = 0; s < 16; ++s) { const float w = __builtin_amdgcn_exp2f(m[s] - mstar); L += w * p.MLPART[(((size_t)b * 16 + s) * 96 + q) * 2 + 1];
            o += *(const f32x4*)(p.OPART + (((size_t)b * 16 + s) * 96 + q) * 256 + lane * 4) * w; }
        o = o * (1.f / L);
        float acc = 0.f;
        for (int c4 = 0; c4 < 64; ++c4) { const float* wp = p.w_uv + (size_t)(4 * c4) * 768 + h * 64 + lane;
            acc += __shfl(o[0], c4) * wp[0] + __shfl(o[1], c4) * wp[768] + __shfl(o[2], c4) * wp[1536] + __shfl(o[3], c4) * wp[2304]; }
        p.CAT[((size_t)MP + b * 8 + t) * 1024 + h * 64 + lane] = (bf16_t)f2bf(acc);
    }
}
}
namespace fk {
constexpr int LDS_MAIN = (SA_LDS > STAGE_BYTES ? SA_LDS : STAGE_BYTES);
constexpr int LDS_BYTES = LDS_MAIN + 64;
constexpr size_t ZERO_BYTES = 16384 + 4096 + (size_t)(9 + 2 + 24) * MT * 4;

__device__ __forceinline__ void ph_prologue(const P& p, LAS unsigned char* lds, int bid, int nb) { p0_prologue(p, (LAS float*)lds, bid, nb); p0_gather_cache(p, bid, nb); }
__device__ __forceinline__ void ph_pre2(const P& p, LAS unsigned char* lds, int bid, int nb) {
    { Gemm g{p.HM, p.BT_MEM, 8, 8, 1024, 1024, 1024, 0}; EpiMemKv e{p.mem_k, p.mem_v, p.MKB, p.MVB, p.g_mem_k}; gemm_phase(lds, g, e, nb, bid); }
    { Gemm g{p.KVBS, p.BT_KV, 2048, 3, 256, 288, 256, 0}; EpiKvUp e{p.KVBS, nullptr, nullptr, p.KINVS, 0}; gemm_phase(lds, g, e, nb, bid); }
}
__device__ __forceinline__ void ph_a1(const P& p, LAS unsigned char* lds, int l, int bid, int nb) {
    Gemm g{p.XB, p.BT_A1 + (size_t)l * 1024 * 1024, 65, 4, 1024, 1024, 1024, 0};
    EpiInA e{p.SSQ + (size_t)(2 * l) * MT, p.U, p.QM, p.g_mem_q + l * 64, p.pool_p + (size_t)l * 8 * 15 * 768, p.pool_s + (size_t)l * 32 * 15 * 768};
    gemm_phase(lds, g, e, nb, bid);
}
__device__ __forceinline__ void ph_a2(const P& p, LAS unsigned char* lds, int l, int bid, int nb) { t_poolprep(p, l, bid, nb); memattn_phase(p, lds, l, bid, nb); }
__device__ __forceinline__ void ph_a3(const P& p, LAS unsigned char* lds, int l, int bid, int nb) {
    Gemm g{p.DIFF, p.BT_MIX + (size_t)l * 768 * 384, 65, 3, 384, 768, 384, 192}; EpiPlainBf16 e{p.CAT, 1024}; gemm_phase(lds, g, e, nb, bid);
}
__device__ __forceinline__ void ph_out(const P& p, LAS unsigned char* lds, int l, int bid, int nb) {
    Gemm g{p.CAT, p.BT_OUT + (size_t)l * 1024 * 1024, 65, 4, 1024, 1024, 1024, 0}; EpiRes e{p.X, p.XB, p.SSQ + (size_t)(2 * l + 1) * MT}; gemm_phase(lds, g, e, nb, bid);
}
__device__ __forceinline__ void ph_ffn1(const P& p, LAS unsigned char* lds, int l, int bid, int nb) {
    Gemm g{p.XB, p.BT_F1 + (size_t)l * 5632 * 1024, 65, 22, 1024, 1024, 1024, 0}; EpiFfnIn e{p.SSQ + (size_t)(2 * l + 1) * MT, p.ACT}; gemm_phase(lds, g, e, nb, bid);
}
__device__ __forceinline__ void ph_ffn2(const P& p, LAS unsigned char* lds, int l, int bid, int nb) {
    Gemm g{p.ACT, p.BT_F2 + (size_t)l * 1024 * 2816, 65, 4, 2816, 2816, 2816, 0}; EpiRes e{p.X, l < 3 ? p.XB : nullptr, l < 3 ? p.SSQ + (size_t)(2 * l + 2) * MT : nullptr}; gemm_phase(lds, g, e, nb, bid);
}
__device__ __forceinline__ void ph_b1(const P& p, LAS unsigned char* lds, int j, int bid, int nb) {
    const int l = 2 + j;
    Gemm g{p.XB, p.BT_B1 + (size_t)j * 1024 * 1024, 65, j == 0 ? 4 : 3, 1024, 1024, 1024, 0};
    EpiInB e{p.SSQ + (size_t)(2 * l) * MT, p.CQ, p.SSQCQ + (size_t)j * MT, p.QM, p.g_mem_q + l * 64, p.CK, j};
    gemm_phase(lds, g, e, nb, bid);
}
__device__ __forceinline__ void ph_b2(const P& p, LAS unsigned char* lds, int j, int bid, int nb) {
    if (j == 0) t_kvrows(p, bid, nb);
    { Gemm g{p.CQ, p.BT_UQ + (size_t)j * 1280 * 384, 65, 5, 384, 384, 384, 0};
      EpiUq e{p.SSQCQ + (size_t)j * MT, p.SSQQ + (size_t)j * MT * 12, p.QF, p.g_q + j * 96, p.g_k_nope, p.g_k_rope, p.ROPEC, p.ROPES}; gemm_phase(lds, g, e, nb, bid); }
    memattn_phase(p, lds, 2 + j, bid, nb);
}
__device__ __forceinline__ void ph_b3(const P& p, LAS unsigned char* lds, int bid, int nb) {
    Gemm g{p.KVB, p.BT_KV, 65, 6, 256, 288, 256, 0}; EpiKvUp e{p.KVB, p.KF, p.VF, p.KINV, MP}; gemm_phase(lds, g, e, nb, bid);
}
__device__ __forceinline__ void ph_b4(const P& p, LAS unsigned char* lds, int j, int bid, int nb) { mla_sample_phase(p, lds, j, bid, nb); mla_prompt_phase(p, lds, j, bid, nb); }
__device__ __forceinline__ void ph_b5(const P& p, int bid, int nb) { mla_sample_combine(p, bid, nb); }

enum { PH_PRO = 0, PH_PRE2, PH_A1, PH_A2, PH_A3, PH_OUT, PH_FFN1, PH_FFN2, PH_B1, PH_B2, PH_B3, PH_B4, PH_B5 };
template <int PH> __global__ void __launch_bounds__(NTHR, 2) k_phase(P p, int l) {
    extern __shared__ __attribute__((aligned(16))) unsigned char shm[];
    LAS unsigned char* lds = (LAS unsigned char*)shm; const int bid = blockIdx.x, nb = gridDim.x;
    if (PH == PH_PRO) ph_prologue(p, lds, bid, nb);
    if (PH == PH_PRE2) ph_pre2(p, lds, bid, nb);
    if (PH == PH_A1) ph_a1(p, lds, l, bid, nb);
    if (PH == PH_A2) ph_a2(p, lds, l, bid, nb);
    if (PH == PH_A3) ph_a3(p, lds, l, bid, nb);
    if (PH == PH_OUT) ph_out(p, lds, l, bid, nb);
    if (PH == PH_FFN1) ph_ffn1(p, lds, l, bid, nb);
    if (PH == PH_FFN2) ph_ffn2(p, lds, l, bid, nb);
    if (PH == PH_B1) ph_b1(p, lds, l, bid, nb);
    if (PH == PH_B2) ph_b2(p, lds, l, bid, nb);
    if (PH == PH_B3) ph_b3(p, lds, bid, nb);
    if (PH == PH_B4) ph_b4(p, lds, l, bid, nb);
    if (PH == PH_B5) ph_b5(p, bid, nb);
}
template <int PH> static void launch_phase(hipStream_t st, const P& p, int l) {
    static bool attr = false; if (!attr) { hipFuncSetAttribute((const void*)k_phase<PH>, hipFuncAttributeMaxDynamicSharedMemorySize, LDS_BYTES); attr = true; }
    hipLaunchKernelGGL((k_phase<PH>), dim3(256), dim3(NTHR), LDS_BYTES, st, p, l);
}

struct WsMap { size_t total; unsigned char* zero_base; };
static WsMap setup(P& p, void* const* d_in, float* out, unsigned char* ws) {
    p.x_prompt = (const float*)d_in[0]; p.x_sample = (const float*)d_in[1]; p.cache_kv = (const float*)d_in[2]; p.state_pool = (const float*)d_in[3];
    p.cache_mem_k = (const float*)d_in[4]; p.cache_mem_v = (const float*)d_in[5]; p.page_table = (const int*)d_in[6]; p.mem_prompt = (const float*)d_in[7];
    p.norm_mix = (const float*)d_in[8]; p.norm_ffn = (const float*)d_in[9]; p.w_out = (const float*)d_in[10]; p.w_ffn_in = (const float*)d_in[11]; p.w_ffn_out = (const float*)d_in[12];
    p.norm_mem = (const float*)d_in[13]; p.w_mem_kv = (const float*)d_in[14]; p.g_mem_q = (const float*)d_in[15]; p.g_mem_k = (const float*)d_in[16]; p.w_in_a = (const float*)d_in[17];
    p.w_pool_grp = (const float*)d_in[18]; p.pool_scale = (const float*)d_in[19]; p.w_in_b = (const float*)d_in[20]; p.g_q_lora = (const float*)d_in[21]; p.w_uq = (const float*)d_in[22];
    p.g_q = (const float*)d_in[23]; p.norm_kv = (const float*)d_in[24]; p.w_dkv = (const float*)d_in[25]; p.g_kv_lora = (const float*)d_in[26]; p.w_uk = (const float*)d_in[27];
    p.w_uv = (const float*)d_in[28]; p.g_k_nope = (const float*)d_in[29]; p.g_k_rope = (const float*)d_in[30];
    p.X = out; p.KVO = out + 17039360; p.pool_p = out + 21831680; p.pool_s = out + 22016000; p.mem_k = out + 22753280; p.mem_v = out + 24850432;
    size_t o = 0; auto take = [&](size_t bytes) { unsigned char* q = ws + o; o += (bytes + 255) & ~(size_t)255; return q; };
    WsMap m; m.zero_base = take(ZERO_BYTES);
    p.bar = (unsigned*)m.zero_base; p.ctl = (unsigned*)(m.zero_base + 16384);
    p.SSQ = (float*)(m.zero_base + 16384 + 4096); p.SSQCQ = p.SSQ + (size_t)9 * MT; p.SSQQ = p.SSQCQ + (size_t)2 * MT;
    p.BT_A1 = (bf16_t*)take((size_t)2 * 1024 * 1024 * 2); p.BT_OUT = (bf16_t*)take((size_t)4 * 1024 * 1024 * 2); p.BT_F1 = (bf16_t*)take((size_t)4 * 5632 * 1024 * 2);
    p.BT_F2 = (bf16_t*)take((size_t)4 * 1024 * 2816 * 2); p.BT_B1 = (bf16_t*)take((size_t)2 * 1024 * 1024 * 2); p.BT_UQ = (bf16_t*)take((size_t)2 * 1280 * 384 * 2);
    p.BT_KV = (bf16_t*)take((size_t)1536 * 256 * 2); p.BT_MEM = (bf16_t*)take((size_t)2048 * 1024 * 2); p.BT_MIX = (bf16_t*)take((size_t)2 * 768 * 384 * 2);
    p.XB = (bf16_t*)take((size_t)MT * 1024 * 2); p.U = (bf16_t*)take((size_t)MT * 768 * 2); p.QM = (bf16_t*)take((size_t)MT * 256 * 2); p.DIFF = (bf16_t*)take((size_t)MT * 768 * 2 + 4096);
    p.CAT = (bf16_t*)take((size_t)MT * 1024 * 2); p.ACT = (bf16_t*)take((size_t)MT * 2816 * 2); p.CQ = (bf16_t*)take((size_t)MT * 384 * 2); p.KVB = (bf16_t*)take((size_t)MT * 288 * 2 + 4096);
    p.QF = (bf16_t*)take((size_t)MT * 1152 * 2); p.KF = (bf16_t*)take((size_t)MP * 1152 * 2); p.VF = (bf16_t*)take((size_t)MP * 768 * 2); p.HM = (bf16_t*)take((size_t)2048 * 1024 * 2);
    p.MKB = (bf16_t*)take((size_t)4 * 2048 * 256 * 2); p.MVB = (bf16_t*)take((size_t)4 * 2048 * 256 * 2); p.MKS = (bf16_t*)take((size_t)4 * 32 * 65536 * 2); p.MVS = (bf16_t*)take((size_t)4 * 32 * 65536 * 2);
    p.KVBS = (bf16_t*)take((size_t)32 * 16384 * 288 * 2 + 4096); p.WUKB = (bf16_t*)take((size_t)256 * 768 * 2);
    p.CK = (float*)take((size_t)MT * 288 * 4); p.KINV = (float*)take((size_t)MT * 12 * 4); p.KINVS = (float*)take((size_t)32 * 16384 * 12 * 4);
    p.ROPEC = (float*)take(2056 * 16 * 4); p.ROPES = (float*)take(2056 * 16 * 4);
    p.OPART = (float*)take((size_t)32 * 16 * 96 * 256 * 4); p.MLPART = (float*)take((size_t)32 * 16 * 96 * 2 * 4);
    m.total = o; return m;
}

static void forward_phases(hipStream_t st, const P& p, const WsMap& m, void (*hook)(int, int, void*), void* hctx) {
    hipMemsetAsync(m.zero_base, 0, ZERO_BYTES, st);
    launch_phase<PH_PRO>(st, p, 0); launch_phase<PH_PRE2>(st, p, 0); if (hook) hook(-1, 0, hctx);
    for (int l = 0; l < 4; ++l) {
        if (l < 2) { launch_phase<PH_A1>(st, p, l); launch_phase<PH_A2>(st, p, l); launch_phase<PH_A3>(st, p, l); }
        else { const int j = l - 2; launch_phase<PH_B1>(st, p, j); launch_phase<PH_B2>(st, p, j); if (j == 0) launch_phase<PH_B3>(st, p, 0); launch_phase<PH_B4>(st, p, j); launch_phase<PH_B5>(st, p, j); }
        if (hook) hook(l, 2, hctx);
        launch_phase<PH_OUT>(st, p, l); if (hook) hook(l, 3, hctx);
        launch_phase<PH_FFN1>(st, p, l); if (hook) hook(l, 4, hctx);
        launch_phase<PH_FFN2>(st, p, l); if (hook) hook(l, 5, hctx);
    }
}
}
extern "C" void kernel_launch(void* const* d_in, const int* in_sizes, int n_in,
                              void* d_out, int out_size, void* d_ws, size_t ws_size,
                              hipStream_t stream) {
    fk::P p; fk::WsMap m = fk::setup(p, d_in, (float*)d_out, (unsigned char*)d_ws);
    if (m.total > ws_size) return;
    fk::forward_phases(stream, p, m, nullptr, nullptr);
}
```
